# Optimizing an MI355X kernel written in HIP

```python
import jax, jax.numpy as jnp
from jax import lax
import numpy as np

D_MODEL = 4096
BATCH = 2
SEQ = 8192
DEPTH = 2
DEC_BATCH = 32
DEC_SEQ = 32
PAST_LEN = 4096

CHUNK = 64
N_EVEN = (DEPTH + 1) // 2
N_ODD = DEPTH // 2
A_DK = 128
A_DV = 128
A_HEADS = D_MODEL // 256
A_W = A_HEADS * A_DK
A_V = A_HEADS * A_DV
B_DK = 128
B_DV = 2 * B_DK
B_HEADS = D_MODEL // 512
B_QK = B_HEADS * B_DK
B_V = B_HEADS * B_DV
EVEN_IN = 2 * A_W + 2 * A_V + 2 * B_QK + 2 * B_V
EVEN_SPLITS = [A_W, 2 * A_W, 2 * A_W + A_V, 2 * A_W + 2 * A_V,
               2 * A_W + 2 * A_V + B_QK, 2 * A_W + 2 * A_V + 2 * B_QK,
               2 * A_W + 2 * A_V + 2 * B_QK + B_V]
ROPE_BASE = 10000.0
D_RNN = D_MODEL * 5 // 4
RG_BLOCKS = 16
RG_BS = D_RNN // RG_BLOCKS
CONV_W = 4
RG_C = 8.0
FF = 4 * D_MODEL
EPS = 1e-6

kernel_name = 'hgrn2_retention_rglru_stream_step'


def rms_norm(x, g):
    xf = x.astype(jnp.float32)
    y = xf * lax.rsqrt(jnp.mean(xf * xf, axis=-1, keepdims=True) + EPS)
    return (y * g.astype(jnp.float32)).astype(x.dtype)


def head_rms(o):
    return o * lax.rsqrt(jnp.mean(o * o, axis=-1, keepdims=True) + EPS)


def head_group_norm(o):
    mu = jnp.mean(o, axis=-1, keepdims=True)
    c = o - mu
    return c * lax.rsqrt(jnp.mean(c * c, axis=-1, keepdims=True) + EPS)


def rotary(x, pos):
    half = x.shape[-1] // 2
    inv = 1.0 / (ROPE_BASE ** jnp.linspace(0.0, 1.0, half, dtype=jnp.float32))
    ang = pos.astype(jnp.float32)[:, None] * inv[None, :]
    cos = jnp.cos(ang)[None, :, None, :]
    sin = jnp.sin(ang)[None, :, None, :]
    x1, x2 = x[..., :half], x[..., half:]
    return jnp.concatenate([x1 * cos - x2 * sin, x2 * cos + x1 * sin], axis=-1)


def ret_log_gamma():
    return jnp.log(1.0 - jnp.exp2(-5.0 - jnp.arange(B_HEADS, dtype=jnp.float32)))


def chunked_gla(q, k, v, log_f, s0):
    B, T, H, K = q.shape
    V = v.shape[-1]
    L = min(CHUNK, T)
    N = T // L

    def blocks(a):
        return a.reshape(B, N, L, H, a.shape[-1]).transpose(1, 0, 3, 2, 4)

    qc, kc, vc, gc = blocks(q), blocks(k), blocks(v), blocks(log_f)
    b = jnp.cumsum(gc, axis=3)
    b_last = b[:, :, :, -1:, :]
    q_in = qc * jnp.exp(b)
    k_in = kc * jnp.exp(-b)
    k_out = kc * jnp.exp(b_last - b)
    mask = jnp.tril(jnp.ones((L, L), dtype=bool))
    attn = jnp.where(mask, jnp.einsum('nbhlk,nbhmk->nbhlm', q_in, k_in), 0.0)
    o_intra = jnp.einsum('nbhlm,nbhmv->nbhlv', attn, vc)
    kv = jnp.einsum('nbhlk,nbhlv->nbhkv', k_out, vc)
    decay = jnp.exp(b_last[:, :, :, 0, :])

    def step(s, inp):
        q_i, kv_i, d_i = inp
        o = jnp.einsum('bhlk,bhkv->bhlv', q_i, s)
        return d_i[..., None] * s + kv_i, o

    s_final, o_inter = lax.scan(step, s0, (q_in, kv, decay))
    o = (o_intra + o_inter).transpose(1, 0, 3, 2, 4).reshape(B, T, H, V)
    return o, s_final


def even_mixer(x, pos, s_a, s_b, w_in, lb, g_a, g_b, w_out):
    B, T, _ = x.shape
    f32 = jnp.float32
    proj = jnp.einsum('btd,de->bte', x, w_in)
    qa, fa, ia, ga, qb, kb, vb, gb = jnp.split(proj.astype(f32), EVEN_SPLITS, axis=-1)

    def heads(a, h):
        return a.reshape(B, T, h, -1)

    lbf = lb.astype(f32)
    f = lbf + (1.0 - lbf) * jax.nn.sigmoid(fa)
    o_a, s_a_new = chunked_gla(heads(jax.nn.silu(qa), A_HEADS), heads(1.0 - f, A_HEADS),
                               heads(ia, A_HEADS), heads(jnp.log(f), A_HEADS), s_a.astype(f32))
    o_a = head_rms(o_a).reshape(B, T, A_V) * g_a.astype(f32) * jax.nn.silu(ga)
    q = rotary(heads(qb, B_HEADS), pos)
    k = rotary(heads(kb, B_HEADS), pos) * (B_DK ** -0.5)
    log_g = jnp.broadcast_to(ret_log_gamma()[None, None, :, None], (B, T, B_HEADS, B_DK))
    o_b, s_b_new = chunked_gla(q, k, heads(vb, B_HEADS), log_g, s_b.astype(f32))
    o_b = head_group_norm(o_b).reshape(B, T, B_V) * g_b.astype(f32) * jax.nn.silu(gb)
    o = jnp.concatenate([o_a, o_b], axis=-1).astype(x.dtype)
    y = jnp.einsum('bte,ed->btd', o, w_out)
    return y, s_a_new.astype(s_a.dtype), s_b_new.astype(s_b.dtype)


def odd_mixer(x, pos, h0, s_conv, w_in, conv_w, conv_b, ga_w, ga_b, gx_w, gx_b, lam, w_out):
    B, T, _ = x.shape
    f32 = jnp.float32
    xy = jnp.einsum('btd,de->bte', x, w_in)
    xb, yb = xy[..., :D_RNN], xy[..., D_RNN:]
    xpad = jnp.concatenate([s_conv.astype(xb.dtype), xb], axis=1)
    new_conv = xpad[:, -(CONV_W - 1):]
    conv = conv_b.astype(f32) + sum(xpad[:, j:j + T].astype(f32) * conv_w[j].astype(f32)
                                    for j in range(CONV_W))
    xc = conv.reshape(B, T, RG_BLOCKS, RG_BS)
    r = jax.nn.sigmoid(jnp.einsum('btnc,ncd->btnd', xc, ga_w.astype(f32)).reshape(B, T, D_RNN)
                       + ga_b.astype(f32))
    i = jax.nn.sigmoid(jnp.einsum('btnc,ncd->btnd', xc, gx_w.astype(f32)).reshape(B, T, D_RNN)
                       + gx_b.astype(f32))
    log_a = -RG_C * r * jax.nn.softplus(-lam.astype(f32))
    a = jnp.exp(log_a)
    first = (pos == 0)[None, :, None]
    mult = jnp.where(first, 1.0, jnp.sqrt(-jnp.expm1(2.0 * log_a)))
    b = mult * (i * conv)
    b = b.at[:, 0].add(a[:, 0] * h0.astype(f32))

    def combine(lhs, rhs):
        a_l, b_l = lhs
        a_r, b_r = rhs
        return a_l * a_r, a_r * b_l + b_r

    _, hs = lax.associative_scan(combine, (a, b), axis=1)
    o = (jax.nn.gelu(yb.astype(f32), approximate=True) * hs).astype(x.dtype)
    y = jnp.einsum('bte,ed->btd', o, w_out)
    return y, hs[:, -1].astype(h0.dtype), new_conv.astype(s_conv.dtype)


def mlp(x, w_up, w_down):
    h = jnp.einsum('btd,df->btf', x, w_up)
    h = jnp.square(jax.nn.relu(h))
    return jnp.einsum('btf,fd->btd', h, w_down)


def trunk(x, pos, s_hgrn, s_ret, s_rglru, s_conv, norm_mix, norm_mlp, norm_final, w_in_even,
          hgrn_lb_logits, hgrn_norm, ret_norm, w_out_even, w_in_odd, conv_w, conv_b, gate_a_w,
          gate_a_b, gate_x_w, gate_x_b, rglru_lambda, w_out_odd, w_up, w_down):
    lb_all = jnp.cumsum(jax.nn.softmax(hgrn_lb_logits.astype(jnp.float32), axis=0), axis=0)
    h = x
    n_hgrn, n_ret, n_rg, n_conv = [], [], [], []
    for l in range(DEPTH):
        hn = rms_norm(h, norm_mix[l])
        if l % 2 == 0:
            e = l // 2
            y, sa, sb = even_mixer(hn, pos, s_hgrn[e], s_ret[e], w_in_even[e], lb_all[l],
                                   hgrn_norm[e], ret_norm[e], w_out_even[e])
            n_hgrn.append(sa)
            n_ret.append(sb)
        else:
            o = l // 2
            y, sh, sc = odd_mixer(hn, pos, s_rglru[o], s_conv[o], w_in_odd[o], conv_w[o], conv_b[o],
                                  gate_a_w[o], gate_a_b[o], gate_x_w[o], gate_x_b[o],
                                  rglru_lambda[o], w_out_odd[o])
            n_rg.append(sh)
            n_conv.append(sc)
        h = h + y
        h = h + mlp(rms_norm(h, norm_mlp[l]), w_up[l], w_down[l])
    out = rms_norm(h, norm_final)
    return out, jnp.stack(n_hgrn), jnp.stack(n_ret), jnp.stack(n_rg), jnp.stack(n_conv)


def setup_inputs(seed: int = 0) -> dict:
    key = jax.random.key(seed)
    ks = jax.random.split(key, 32)
    f32 = jnp.float32

    def nrm(k, shape, scale):
        return jax.random.normal(k, shape, f32) * scale

    u = jax.random.uniform(ks[24], (N_ODD, D_RNN), f32, minval=0.9, maxval=0.999)
    sa = u ** (1.0 / RG_C)
    lam = jnp.log(sa) - jnp.log1p(-sa)
    return {
        'x_prompt': nrm(ks[0], (BATCH, SEQ, D_MODEL), 1.0),
        'x_sample': nrm(ks[1], (DEC_BATCH, DEC_SEQ, D_MODEL), 1.0),
        'state_hgrn': nrm(ks[2], (N_EVEN, DEC_BATCH, A_HEADS, A_DK, A_DV), 0.5),
        'state_ret': nrm(ks[3], (N_EVEN, DEC_BATCH, B_HEADS, B_DK, B_DV), 1.0),
        'state_rglru': nrm(ks[4], (N_ODD, DEC_BATCH, D_RNN), 0.5),
        'state_conv': nrm(ks[5], (N_ODD, DEC_BATCH, CONV_W - 1, D_RNN), 1.0),
        'norm_mix': 1.0 + nrm(ks[6], (DEPTH, D_MODEL), 0.02),
        'norm_mlp': 1.0 + nrm(ks[7], (DEPTH, D_MODEL), 0.02),
        'norm_final': 1.0 + nrm(ks[8], (D_MODEL,), 0.02),
        'w_in_even': nrm(ks[9], (N_EVEN, D_MODEL, EVEN_IN), D_MODEL ** -0.5),
        'hgrn_lb_logits': nrm(ks[10], (DEPTH + 1, A_W), 0.1),
        'hgrn_norm': 1.0 + nrm(ks[11], (N_EVEN, A_V), 0.02),
        'ret_norm': 1.0 + nrm(ks[12], (N_EVEN, B_V), 0.02),
        'w_out_even': nrm(ks[13], (N_EVEN, A_V + B_V, D_MODEL), (A_V + B_V) ** -0.5),
        'w_in_odd': nrm(ks[14], (N_ODD, D_MODEL, 2 * D_RNN), D_MODEL ** -0.5),
        'conv_w': nrm(ks[15], (N_ODD, CONV_W, D_RNN), CONV_W ** -0.5),
        'conv_b': nrm(ks[16], (N_ODD, D_RNN), 0.01),
        'gate_a_w': nrm(ks[17], (N_ODD, RG_BLOCKS, RG_BS, RG_BS), RG_BS ** -0.5),
        'gate_a_b': nrm(ks[18], (N_ODD, D_RNN), 0.01),
        'gate_x_w': nrm(ks[19], (N_ODD, RG_BLOCKS, RG_BS, RG_BS), RG_BS ** -0.5),
        'gate_x_b': nrm(ks[20], (N_ODD, D_RNN), 0.01),
        'rglru_lambda': lam,
        'w_out_odd': nrm(ks[21], (N_ODD, D_RNN, D_MODEL), D_RNN ** -0.5),
        'w_up': nrm(ks[22], (DEPTH, D_MODEL, FF), D_MODEL ** -0.5),
        'w_down': nrm(ks[23], (DEPTH, FF, D_MODEL), FF ** -0.5),
    }


def reference(x_prompt, x_sample, state_hgrn, state_ret, state_rglru, state_conv, norm_mix,
              norm_mlp, norm_final, w_in_even, hgrn_lb_logits, hgrn_norm, ret_norm, w_out_even,
              w_in_odd, conv_w, conv_b, gate_a_w, gate_a_b, gate_x_w, gate_x_b, rglru_lambda,
              w_out_odd, w_up, w_down):
    dt = x_prompt.dtype
    z_hgrn = jnp.zeros((N_EVEN, BATCH, A_HEADS, A_DK, A_DV), dt)
    z_ret = jnp.zeros((N_EVEN, BATCH, B_HEADS, B_DK, B_DV), dt)
    z_rg = jnp.zeros((N_ODD, BATCH, D_RNN), dt)
    z_conv = jnp.zeros((N_ODD, BATCH, CONV_W - 1, D_RNN), dt)
    pos_p = jnp.arange(SEQ, dtype=jnp.int32)
    pos_s = PAST_LEN + jnp.arange(DEC_SEQ, dtype=jnp.int32)
    y_prompt, hg_p, rt_p, rg_p, cv_p = trunk(
        x_prompt, pos_p, z_hgrn, z_ret, z_rg, z_conv, norm_mix, norm_mlp, norm_final, w_in_even,
        hgrn_lb_logits, hgrn_norm, ret_norm, w_out_even, w_in_odd, conv_w, conv_b, gate_a_w,
        gate_a_b, gate_x_w, gate_x_b, rglru_lambda, w_out_odd, w_up, w_down)
    y_sample, hg_s, rt_s, rg_s, cv_s = trunk(
        x_sample, pos_s, state_hgrn, state_ret, state_rglru, state_conv, norm_mix, norm_mlp,
        norm_final, w_in_even, hgrn_lb_logits, hgrn_norm, ret_norm, w_out_even, w_in_odd, conv_w,
        conv_b, gate_a_w, gate_a_b, gate_x_w, gate_x_b, rglru_lambda, w_out_odd, w_up, w_down)
    return (y_prompt, y_sample, hg_p, rt_p, rg_p, cv_p, hg_s, rt_s, rg_s, cv_s)
```

```cpp
#include <hip/hip_runtime.h>
#include <cstdio>
#include <cstdint>

#define GAS __attribute__((address_space(1)))
#define LAS __attribute__((address_space(3)))
typedef unsigned short bf16_t;
typedef short bf16x8 __attribute__((ext_vector_type(8)));
typedef float f32x4 __attribute__((ext_vector_type(4)));
typedef float f32x2 __attribute__((ext_vector_type(2)));
typedef unsigned u32x4 __attribute__((ext_vector_type(4)));
typedef unsigned u32x2 __attribute__((ext_vector_type(2)));


constexpr int D = 4096, SEQ = 8192, NBATCH = 2, DECB = 32, DECS = 32, PAST = 4096;
constexpr int MP = NBATCH * SEQ;
constexpr int MS = DECB * DECS;
constexpr int M = MP + MS;
constexpr int EIN = 14336, FF = 16384, DR = 5120, OIN = 10240;
constexpr float EPS = 1e-6f;
constexpr size_t O_Y = 0;
constexpr size_t O_HGP = (size_t)M * D;
constexpr size_t O_RTP = O_HGP + 524288;
constexpr size_t O_RGP = O_RTP + 524288;
constexpr size_t O_CVP = O_RGP + 10240;
constexpr size_t O_HGS = O_CVP + 30720;
constexpr size_t O_RTS = O_HGS + 8388608;
constexpr size_t O_RGS = O_RTS + 8388608;
constexpr size_t O_CVS = O_RGS + 163840;
constexpr size_t O_END = O_CVS + 491520;

constexpr size_t MiB = 1u << 20;
constexpr size_t WS_CTL = 0, CTL_ZERO_BYTES = 32 * 1024;
constexpr size_t WS_LB = 1 * MiB, WS_SP8 = 1 * MiB + 16384;
constexpr size_t WS_ROT = 2 * MiB;
constexpr size_t WS_AGA = 6 * MiB, WS_AGH = 11 * MiB, WS_CAR = 16 * MiB;
constexpr size_t WS_WINE = 24 * MiB, WS_WOUTE = 136 * MiB, WS_WUP = 168 * MiB, WS_WDN = 424 * MiB, WS_WINO = 680 * MiB, WS_WOUTO = 760 * MiB, WS_GW = 800 * MiB;
constexpr size_t WS_XN = 810 * MiB;
constexpr size_t WS_BIG = 946 * MiB;
constexpr size_t WS_PROJ = WS_BIG, WS_ORAW = WS_BIG + 476 * MiB  , WS_MIXO = WS_BIG + 748 * MiB;
constexpr size_t WS_HID = WS_BIG;
constexpr size_t WS_PROJ2 = WS_BIG, WS_XC = WS_BIG + 340 * MiB, WS_GATES = WS_BIG + 514 * MiB;
constexpr size_t WS_PART = WS_BIG + 884 * MiB;
constexpr size_t WS_END = WS_PART + 64 * MiB;
constexpr int CW_TMO = 0, CW_BAR = 4096;
constexpr int GWK = 384, GWN = 768;

constexpr int RING_BYTES = 131072;
constexpr int LDSCTL_OFF = RING_BYTES, MISC_OFF = LDSCTL_OFF + 320;
constexpr int LDS_BYTES = 147456;
constexpr int NWAVES = 8;

__device__ __forceinline__ float fexp(float x) { return __builtin_amdgcn_exp2f(x * 1.4426950408889634f); }
__device__ __forceinline__ float flog(float x) { return __builtin_amdgcn_logf(x) * 0.6931471805599453f; }
__device__ __forceinline__ float frcp(float x) { return __builtin_amdgcn_rcpf(x); }
__device__ __forceinline__ float sigm(float x) { return frcp(1.0f + fexp(-x)); }
typedef __bf16 bf16x2_t __attribute__((ext_vector_type(2)));
__device__ __forceinline__ unsigned cvt_pk_bf16(float lo, float hi) { const f32x2 v = {lo, hi}; const bf16x2_t r = __builtin_convertvector(v, bf16x2_t); return __builtin_bit_cast(unsigned, r); }
__device__ __forceinline__ float bflo(unsigned w) { return __uint_as_float(w << 16); }
__device__ __forceinline__ float bfhi(unsigned w) { return __uint_as_float(w & 0xffff0000u); }
__device__ __forceinline__ float bf1(bf16_t b) { return __uint_as_float(((unsigned)b) << 16); }
template <int CTRL> __device__ __forceinline__ float dpp_f(float v) { return __builtin_bit_cast(float, __builtin_amdgcn_update_dpp(0, __builtin_bit_cast(int, v), CTRL, 0xf, 0xf, true)); }
__device__ __forceinline__ float row16_sum(float v) { v += dpp_f<0xB1>(v); v += dpp_f<0x4E>(v); v += dpp_f<0x141>(v); v += dpp_f<0x140>(v); return v; }
__device__ __forceinline__ float wave_sum(float v) { v = row16_sum(v); v += __shfl_xor(v, 16); v += __shfl_xor(v, 32); return v; }
__device__ __forceinline__ int tid_l() { int t = (int)__builtin_amdgcn_workitem_id_x(); asm volatile("" : "+v"(t)); return t; }
#define LDS_WAIT() asm volatile("s_waitcnt lgkmcnt(0)" ::: "memory")
#define VM_WAIT() asm volatile("s_waitcnt vmcnt(0)" ::: "memory")

namespace pg8 {
constexpr int BM = 256, BK = 64, HALF = 128, HTB = HALF * BK * 2, STAGE_BYTES = 8 * HTB, NXCD = 8, WGM = 4;
__host__ __device__ __forceinline__ int lds_byte(int r, int c) { const int st = (r >> 4) * 2 + (c >> 5), rr = r & 15, cc = c & 31, ob = rr * 64 + cc * 2; return st * 1024 + (ob ^ (((ob >> 9) & 1) << 5)); }
__host__ __device__ __forceinline__ void stage_rc(int b, int& R, int& C) { const int st = b / 1024, sb = b % 1024, swz = sb ^ (((sb >> 9) & 1) << 5); R = (st >> 1) * 16 + swz / 64; C = (st & 1) * 32 + (swz % 64) / 2; }
__host__ __device__ __forceinline__ int perm32(int rho) { const int n = rho >> 4, i = rho & 15; return 8 * (i >> 2) + 4 * n + (i & 3); }

struct Unit { int pm, pn, g; };
struct Gemm { const bf16_t* A; const bf16_t* Bt; int lda, ldb, K; size_t ga, gb; };

struct StaticOrder {
    int nM, nN, nwg, G, c;
    __device__ void init(int M_, int N_, int G_, int c_) { nM = M_ / BM; nN = N_ / BM; nwg = nM * nN; G = G_; c = c_; }
    __device__ bool next(int i, Unit& u) const {
        const long L = (long)i * G + c; if (L >= nwg) return false;
        int wgid = (int)L; { const int q = nwg / NXCD, r = nwg % NXCD, xcd = wgid % NXCD, off = wgid / NXCD; wgid = (xcd < r ? xcd * (q + 1) : r * (q + 1) + (xcd - r) * q) + off; }
        const int nig = WGM * nN, gid = wgid / nig, fm = gid * WGM, gsz = (nM - fm) < WGM ? (nM - fm) : WGM;
        u.pm = fm + ((wgid % nig) % gsz); u.pn = (wgid % nig) / gsz; u.g = 0; return true;
    }
};
struct GroupOrder {
    int G, c;
    __device__ bool next(int i, Unit& u) const {
        const int L = i * G + c; if (L >= 68 * 48) return false;
        u.pm = L / 48; const int rem = L % 48; u.g = rem / 3; u.pn = rem % 3; return true;
    }
};

struct SplitOrder {
    int G, c;
    __device__ bool next(int i, Unit& u) const {
        const int L = i * G + c; if (L >= 256) return false;
        u.g = L & 3; u.pn = (L >> 2) & 15; u.pm = MP / BM + (L >> 6); return true;
    }
};
template <int ACT  > struct EpiBf16 {
    static constexpr bool PERM = true;
    bf16_t* O; int ldc; const float* rs;
    __device__ __forceinline__ void operator()(const f32x4 (&acc)[2][2][4][2], const Unit& u, int wr, int wc, int fr, int fq) const {
        const int row0 = u.pm * BM + wr * 64 + fr; const int col0 = u.pn * BM + wc * 32 + 8 * fq;
        float sc[2][4];
#pragma unroll
        for (int ai = 0; ai < 2; ++ai)
#pragma unroll
            for (int m = 0; m < 4; ++m) sc[ai][m] = rs ? rs[row0 + ai * HALF + m * 16] : 1.0f;
#pragma unroll
        for (int ai = 0; ai < 2; ++ai)
#pragma unroll
            for (int m = 0; m < 4; ++m) { bf16_t* rowp = O + (size_t)(row0 + ai * HALF + m * 16) * ldc + col0;
#pragma unroll
                for (int bj = 0; bj < 2; ++bj) { f32x4 v0 = acc[ai][bj][m][0] * sc[ai][m], v1 = acc[ai][bj][m][1] * sc[ai][m];
                    if (ACT == 1) {
#pragma unroll
                        for (int j = 0; j < 4; ++j) { const float a = fmaxf(v0[j], 0.f), b = fmaxf(v1[j], 0.f); v0[j] = a * a; v1[j] = b * b; } }
                    u32x4 w; w.x = cvt_pk_bf16(v0[0], v0[1]); w.y = cvt_pk_bf16(v0[2], v0[3]); w.z = cvt_pk_bf16(v1[0], v1[1]); w.w = cvt_pk_bf16(v1[2], v1[3]);
                    __builtin_nontemporal_store(w, (u32x4*)(rowp + bj * HALF)); } }
    }
};
struct EpiGates {
    static constexpr bool PERM = true;
    bf16_t* O; const float* ba; const float* bx;
    __device__ __forceinline__ void operator()(const f32x4 (&acc)[2][2][4][2], const Unit& u, int wr, int wc, int fr, int fq) const {
        const int row0 = u.pm * BM + wr * 64 + fr;
#pragma unroll
        for (int bj = 0; bj < 2; ++bj) {
            const int cl = u.pn * BM + bj * HALF + wc * 32 + 8 * fq;
            if (cl < 640) {
                const int gate = cl >= 320 ? 1 : 0; const int ch = u.g * 320 + cl - gate * 320;
                const float* bp = (gate ? bx : ba) + ch; const f32x4 b0 = *(const f32x4*)bp, b1 = *(const f32x4*)(bp + 4);
                bf16_t* colp = O + gate * DR + ch;
#pragma unroll
                for (int ai = 0; ai < 2; ++ai)
#pragma unroll
                    for (int m = 0; m < 4; ++m) { f32x4 v0 = acc[ai][bj][m][0] + b0, v1 = acc[ai][bj][m][1] + b1;
#pragma unroll
                        for (int j = 0; j < 4; ++j) { v0[j] = sigm(v0[j]); v1[j] = sigm(v1[j]); }
                        u32x4 w; w.x = cvt_pk_bf16(v0[0], v0[1]); w.y = cvt_pk_bf16(v0[2], v0[3]); w.z = cvt_pk_bf16(v1[0], v1[1]); w.w = cvt_pk_bf16(v1[2], v1[3]);
                        __builtin_nontemporal_store(w, (u32x4*)(colp + (size_t)(row0 + ai * HALF + m * 16) * OIN)); }
            }
        }
    }
};
struct EpiResF32 {
    static constexpr bool PERM = false;
    const float* baseP; const float* baseS; float* out;
    __device__ __forceinline__ void operator()(const f32x4 (&acc)[2][2][4][2], const Unit& u, int wr, int wc, int fr, int fq) const {
        const int row0 = u.pm * BM + wr * 64 + fr, col0 = u.pn * BM + wc * 32 + 4 * fq;
        const float* bb = (u.pm < MP / BM) ? baseP + (size_t)row0 * D : baseS + (size_t)(row0 - MP) * D;
        float* ob = out + (size_t)row0 * D + col0; bb += col0;
#pragma unroll
        for (int ai = 0; ai < 2; ++ai) {
            f32x4 bs[4][2][2];
#pragma unroll
            for (int m = 0; m < 4; ++m)
#pragma unroll
                for (int bj = 0; bj < 2; ++bj)
#pragma unroll
                    for (int n = 0; n < 2; ++n) bs[m][bj][n] = *(const f32x4*)(bb + (size_t)(ai * HALF + m * 16) * D + bj * HALF + n * 16);
            asm volatile("" ::: "memory");
#pragma unroll
            for (int m = 0; m < 4; ++m)
#pragma unroll
                for (int bj = 0; bj < 2; ++bj)
#pragma unroll
                    for (int n = 0; n < 2; ++n) __builtin_nontemporal_store(bs[m][bj][n] + acc[ai][bj][m][n], (f32x4*)(ob + (size_t)(ai * HALF + m * 16) * D + bj * HALF + n * 16));
            asm volatile("" ::: "memory"); }
    }
};
template <bool XBASE> struct EpiResNorm {
    static constexpr bool PERM = true;
    const float* xbase; bf16_t* HB; float* SSP;
    __device__ __forceinline__ void operator()(const f32x4 (&acc)[2][2][4][2], const Unit& u, int wr, int wc, int fr, int fq) const {
        const int row0 = u.pm * BM + wr * 64 + fr, col0 = u.pn * BM + wc * 32 + 8 * fq;
        const float* xb = xbase + (size_t)row0 * D + col0; bf16_t* hb = HB + (size_t)row0 * D + col0;
#pragma unroll
        for (int ai = 0; ai < 2; ++ai) {
            f32x4 b0[4][2], b1[4][2];
#pragma unroll
            for (int m = 0; m < 4; ++m)
#pragma unroll
                for (int bj = 0; bj < 2; ++bj) { const size_t ro = (size_t)(ai * HALF + m * 16) * D + bj * HALF;
                    if (XBASE) { b0[m][bj] = *(const f32x4*)(xb + ro); b1[m][bj] = *(const f32x4*)(xb + ro + 4); }
                    else { const u32x4 w = *(const u32x4*)(hb + ro); b0[m][bj] = (f32x4){bflo(w.x), bfhi(w.x), bflo(w.y), bfhi(w.y)}; b1[m][bj] = (f32x4){bflo(w.z), bfhi(w.z), bflo(w.w), bfhi(w.w)}; } }
            asm volatile("" ::: "memory");
#pragma unroll
            for (int m = 0; m < 4; ++m) { float ss = 0.f; const size_t ro = (size_t)(ai * HALF + m * 16) * D;
#pragma unroll
                for (int bj = 0; bj < 2; ++bj) { const f32x4 h0 = b0[m][bj] + acc[ai][bj][m][0], h1 = b1[m][bj] + acc[ai][bj][m][1];
                    u32x4 w; w.x = cvt_pk_bf16(h0[0], h0[1]); w.y = cvt_pk_bf16(h0[2], h0[3]); w.z = cvt_pk_bf16(h1[0], h1[1]); w.w = cvt_pk_bf16(h1[2], h1[3]); *(u32x4*)(hb + ro + bj * HALF) = w;
                    const float r0 = bflo(w.x), r1 = bfhi(w.x), r2 = bflo(w.y), r3 = bfhi(w.y), r4 = bflo(w.z), r5 = bfhi(w.z), r6 = bflo(w.w), r7 = bfhi(w.w);
                    ss += ((r0 * r0 + r1 * r1) + (r2 * r2 + r3 * r3)) + ((r4 * r4 + r5 * r5) + (r6 * r6 + r7 * r7)); }
                ss += __shfl_xor(ss, 16); ss += __shfl_xor(ss, 32);
                if (fq == 0) SSP[(size_t)(row0 + ai * HALF + m * 16) * 64 + u.pn * 4 + wc] = ss; }
            asm volatile("" ::: "memory"); }
    }
};
struct EpiPart {
    static constexpr bool PERM = true;
    bf16_t* P;
    __device__ __forceinline__ void operator()(const f32x4 (&acc)[2][2][4][2], const Unit& u, int wr, int wc, int fr, int fq) const {
        const int row0 = (u.pm - MP / BM) * BM + wr * 64 + fr, col0 = u.pn * BM + wc * 32 + 8 * fq;
        bf16_t* ob = P + ((size_t)u.g * MS + row0) * D + col0;
#pragma unroll
        for (int ai = 0; ai < 2; ++ai)
#pragma unroll
            for (int m = 0; m < 4; ++m) { const size_t ro = (size_t)(ai * HALF + m * 16) * D;
#pragma unroll
                for (int bj = 0; bj < 2; ++bj) { const f32x4 v0 = acc[ai][bj][m][0], v1 = acc[ai][bj][m][1];
                    u32x4 w; w.x = cvt_pk_bf16(v0[0], v0[1]); w.y = cvt_pk_bf16(v0[2], v0[3]); w.z = cvt_pk_bf16(v1[0], v1[1]); w.w = cvt_pk_bf16(v1[2], v1[3]);
                    *(u32x4*)(ob + ro + bj * HALF) = w; } }
    }
};

template <class Epi, class Sched, bool ALIGN_EPI>
__device__ __forceinline__ void gemm_phase(LAS unsigned char* lds, const Gemm g, const Sched& S, const Epi& E) {
    const int tid = tid_l(), wid = __builtin_amdgcn_readfirstlane(tid >> 6), lane = tid & 63, wr = wid >> 2, wc = wid & 3, fr = lane & 15, fq = lane >> 4;
    const int K = g.K, nt = K / BK;
    unsigned voffA[2], voffB[2];
#pragma unroll
    for (int i = 0; i < 2; ++i) { int R, C; stage_rc(tid * 16 + i * 8192, R, C); const int Rb = Epi::PERM ? ((R & ~31) + perm32(R & 31)) : R;
        voffA[i] = (unsigned)(R * g.lda + C) * 2u; voffB[i] = (unsigned)(Rb * g.ldb + C) * 2u; }
    const size_t kstep = (size_t)(BK * 2);
    const size_t hA = (size_t)HALF * g.lda * 2, hB = (size_t)HALF * g.ldb * 2;
    const unsigned ldsw = (unsigned)wid * 1024u;
    const int aoff = lds_byte(wr * 64 + fr, fq * 8), boff = lds_byte(wc * 32 + fr, fq * 8);
#define PG8_SA(b, h) (((b) * 2 + (h)) * HTB)
#define PG8_SB(b, h) ((4 + (b) * 2 + (h)) * HTB)
#define PG8_STAGE(bufoff, gbase, voff) do { _Pragma("unroll") for (int _i = 0; _i < 2; ++_i) \
        __builtin_amdgcn_global_load_lds((const unsigned*)((const char*)(gbase) + (voff)[_i]), (LAS unsigned*)(lds + (bufoff) + ldsw + _i * 8192), 16, 0, 0); } while (0)
#define PG8_LDA(dst, b, h) do { _Pragma("unroll") for (int m = 0; m < 4; ++m) _Pragma("unroll") for (int k = 0; k < 2; ++k) dst[m][k] = *(const LAS bf16x8*)(lds + PG8_SA(b, h) + aoff + m * 2048 + k * 1024); } while (0)
#define PG8_LDB(dst, b, h) do { _Pragma("unroll") for (int n = 0; n < 2; ++n) _Pragma("unroll") for (int k = 0; k < 2; ++k) dst[n][k] = *(const LAS bf16x8*)(lds + PG8_SB(b, h) + boff + n * 2048 + k * 1024); } while (0)
#define PG8_MMA(ai, bj, At, Bt) do { __builtin_amdgcn_s_setprio(1); _Pragma("unroll") for (int m = 0; m < 4; ++m) _Pragma("unroll") for (int n = 0; n < 2; ++n) _Pragma("unroll") for (int k = 0; k < 2; ++k) \
        acc[ai][bj][m][n] = __builtin_amdgcn_mfma_f32_16x16x32_bf16(Bt[n][k], At[m][k], acc[ai][bj][m][n], 0, 0, 0); __builtin_amdgcn_s_setprio(0); } while (0)
#define PG8_WAIT_V(n) asm volatile("s_waitcnt vmcnt(" #n ")" ::: "memory")
#define PG8_WAIT_L(n) asm volatile("s_waitcnt lgkmcnt(" #n ")" ::: "memory")
#define PG8_BAR __builtin_amdgcn_s_barrier()
#define PG8_SCHED __builtin_amdgcn_sched_barrier(0)
    Unit cur, nxt; int ui = 0;
    if (!S.next(0, cur)) return;
    f32x4 acc[2][2][4][2];
#pragma unroll
    for (int a = 0; a < 2; ++a)
#pragma unroll
        for (int b = 0; b < 2; ++b)
#pragma unroll
            for (int m = 0; m < 4; ++m)
#pragma unroll
                for (int n = 0; n < 2; ++n) acc[a][b][m][n] = (f32x4){0.f, 0.f, 0.f, 0.f};
    bf16x8 At[4][2], B0[2][2], B1[2][2];
    const char* cA = (const char*)g.A + (size_t)cur.pm * 2 * hA + (size_t)cur.g * g.ga; const char* cB = (const char*)g.Bt + (size_t)cur.pn * 2 * hB + (size_t)cur.g * g.gb;
    PG8_STAGE(PG8_SB(0, 0), cB, voffB); PG8_STAGE(PG8_SB(0, 1), cB + hB, voffB); PG8_STAGE(PG8_SA(0, 0), cA, voffA); PG8_STAGE(PG8_SA(0, 1), cA + hA, voffA);
    if (wr == 1) PG8_BAR;
    PG8_WAIT_V(2); PG8_BAR;
    PG8_STAGE(PG8_SB(1, 0), cB + kstep, voffB); PG8_STAGE(PG8_SA(1, 0), cA + kstep, voffA); PG8_STAGE(PG8_SB(1, 1), cB + hB + kstep, voffB);
    PG8_WAIT_V(6); PG8_BAR;
    for (;;) {
        const bool has_next = S.next(ui + 1, nxt);
        const char* nA = has_next ? (const char*)g.A + (size_t)nxt.pm * 2 * hA + (size_t)nxt.g * g.ga : cA; const char* nB = has_next ? (const char*)g.Bt + (size_t)nxt.pn * 2 * hB + (size_t)nxt.g * g.gb : cB;
#pragma nounroll
        for (int t = 0; t < nt; t += 2) {
            const bool last = (t == nt - 2);
            const char* a1 = cA + (size_t)(t + 1) * kstep;
            const char* a2 = last ? nA : cA + (size_t)(t + 2) * kstep; const char* b2 = last ? nB : cB + (size_t)(t + 2) * kstep;
            const char* a3 = a2 + kstep; const char* b3 = b2 + kstep;
            PG8_LDB(B0, 0, 0); PG8_LDB(B1, 0, 1); PG8_SCHED; PG8_LDA(At, 0, 0); PG8_STAGE(PG8_SA(1, 1), a1 + hA, voffA);
            PG8_WAIT_V(8); PG8_WAIT_L(0); PG8_BAR; PG8_MMA(0, 0, At, B0); PG8_MMA(0, 1, At, B1); PG8_BAR; PG8_SCHED;
            PG8_LDA(At, 0, 1); PG8_STAGE(PG8_SB(0, 0), b2, voffB); PG8_STAGE(PG8_SB(0, 1), b2 + hB, voffB); PG8_STAGE(PG8_SA(0, 0), a2, voffA);
            PG8_WAIT_V(8); PG8_WAIT_L(0); PG8_BAR; PG8_MMA(1, 0, At, B0); PG8_MMA(1, 1, At, B1); PG8_BAR; PG8_SCHED;
            PG8_LDB(B0, 1, 0); PG8_LDB(B1, 1, 1); PG8_SCHED; PG8_LDA(At, 1, 0); PG8_STAGE(PG8_SA(0, 1), a2 + hA, voffA);
            PG8_WAIT_V(8); PG8_WAIT_L(0); PG8_BAR; PG8_MMA(0, 0, At, B0); PG8_MMA(0, 1, At, B1); PG8_BAR; PG8_SCHED;
            PG8_LDA(At, 1, 1); PG8_STAGE(PG8_SB(1, 0), b3, voffB); PG8_STAGE(PG8_SB(1, 1), b3 + hB, voffB); PG8_STAGE(PG8_SA(1, 0), a3, voffA);
            PG8_WAIT_V(8); PG8_WAIT_L(0); PG8_BAR; PG8_MMA(1, 0, At, B0); PG8_MMA(1, 1, At, B1); PG8_BAR; PG8_SCHED;
        }
        if constexpr (ALIGN_EPI) { if (wr == 0) PG8_BAR; }
        E(acc, cur, wr, wc, fr, fq);
        if (!has_next) break;
#pragma unroll
        for (int a = 0; a < 2; ++a)
#pragma unroll
            for (int b = 0; b < 2; ++b)
#pragma unroll
                for (int m = 0; m < 4; ++m)
#pragma unroll
                    for (int n = 0; n < 2; ++n) acc[a][b][m][n] = (f32x4){0.f, 0.f, 0.f, 0.f};
        cur = nxt; cA = nA; cB = nB; ++ui;
        if constexpr (ALIGN_EPI) { if (wr == 1) PG8_BAR; }
    }
    PG8_WAIT_V(0);
    if constexpr (!ALIGN_EPI) { if (wr == 0) PG8_BAR; }
    PG8_BAR;
#undef PG8_SA
#undef PG8_SB
#undef PG8_STAGE
#undef PG8_LDA
#undef PG8_LDB
#undef PG8_MMA
#undef PG8_WAIT_V
#undef PG8_WAIT_L
#undef PG8_BAR
#undef PG8_SCHED
}
}

#define XB_TMO      128
#define XB_XCNT(j)  (256  + 64 * (j))
#define XB_XSUB(j)  (1280 + 64 * (j))
#define XB_XGEN(j)  (2304 + 64 * (j))
#define XB_TOP      3328
#define XB_TOPGEN   3392
#define XCD_BAR_WORDS 3456
#define XB_SPIN_CAP (1u << 18)
__device__ __forceinline__ unsigned xb_ld(unsigned* p)              { return __hip_atomic_load(p, __ATOMIC_RELAXED, __HIP_MEMORY_SCOPE_AGENT); }
__device__ __forceinline__ unsigned xb_add(unsigned* p, unsigned v) { return __hip_atomic_fetch_add(p, v, __ATOMIC_RELAXED, __HIP_MEMORY_SCOPE_AGENT); }
__device__ __forceinline__ unsigned xb_xcc_id() { return (unsigned)__builtin_amdgcn_s_getreg((3 << 11) | 20) & 0xFu; }
#define XB_SPIN(cond, bar) do { unsigned _sp = 0; while (cond) { __builtin_amdgcn_s_sleep(1); \
    if ((++_sp & 255u) == 0u) { if (xb_ld(&(bar)[XB_TMO])) break; if (_sp > XB_SPIN_CAP) { atomicAdd(&(bar)[XB_TMO], 1u); break; } } } } while (0)
struct XcdBarrier { unsigned* bar; unsigned x; volatile LAS unsigned* st; };
__device__ __forceinline__ XcdBarrier xcd_barrier_post(unsigned* bar, volatile LAS unsigned* st) {
    XcdBarrier b; b.bar = bar; b.x = xb_xcc_id(); b.st = st;
    if (threadIdx.x == 0) (void)xb_add(&bar[XB_XCNT(b.x)], 1u);
    return b;
}
__device__ __forceinline__ void xcd_barrier_complete(unsigned* bar, unsigned x, unsigned& nloc, unsigned& nx) {
    const unsigned G = gridDim.x * gridDim.y * gridDim.z;
    unsigned sum, cnt, mine, sp = 0u;
    for (;;) {
        sum = 0u; cnt = 0u; mine = 0u;
#pragma unroll
        for (unsigned j = 0; j < 16; ++j) { const unsigned c = xb_ld(&bar[XB_XCNT(j)]); sum += c; cnt += (c > 0u) ? 1u : 0u; mine = (j == x) ? c : mine; }
        if (sum == G) break;
        __builtin_amdgcn_s_sleep(1);
        if ((++sp & 255u) == 0u) { if (xb_ld(&bar[XB_TMO])) break; if (sp > XB_SPIN_CAP) { atomicAdd(&bar[XB_TMO], 1u); break; } }
    }
    nloc = mine > 0u ? mine : 1u; nx = cnt > 0u ? cnt : 1u;
}
__device__ __forceinline__ void xcd_barrier(const XcdBarrier& b) {
    asm volatile("s_waitcnt vmcnt(0)" ::: "memory");
    __syncthreads();
    if (threadIdx.x == 0) {
        unsigned* bar = b.bar;
        __builtin_amdgcn_s_waitcnt(0);
        unsigned nloc = b.st[0], nx = b.st[1];
        if (nloc == 0u) { xcd_barrier_complete(bar, b.x, nloc, nx); b.st[0] = nloc; b.st[1] = nx; }
        const unsigned old = xb_add(&bar[XB_XSUB(b.x)], 1u);
        const unsigned gen = old / nloc;
        if (old + 1u == (gen + 1u) * nloc) {
            __builtin_amdgcn_fence(__ATOMIC_RELEASE, "agent");
            asm volatile("s_waitcnt vmcnt(0)" ::: "memory");
            const unsigned og = xb_add(&bar[XB_TOP], 1u);
            const unsigned tg = og / nx;
            if (og + 1u == (tg + 1u) * nx) xb_add(&bar[XB_TOPGEN], 1u);
            else XB_SPIN(xb_ld(&bar[XB_TOPGEN]) == tg, bar);
            __builtin_amdgcn_fence(__ATOMIC_ACQUIRE, "agent");
            xb_add(&bar[XB_XGEN(b.x)], 1u);
            asm volatile("s_waitcnt vmcnt(0)" ::: "memory");
        } else {
            XB_SPIN(xb_ld(&bar[XB_XGEN(b.x)]) == gen, bar);
            __builtin_amdgcn_fence(__ATOMIC_ACQUIRE, "agent");
            asm volatile("s_waitcnt vmcnt(0)" ::: "memory");
        }
    }
    __syncthreads();
}

__device__ __forceinline__ void p0_transpose_item(const float* W, int ldw, bf16_t* WT, int ldo, int k0, int n0, LAS float* scr, int lane, const float* gain = nullptr) {
#pragma unroll
    for (int i = 0; i < 32; ++i) { const int kk = 2 * i + (lane >> 5); scr[kk * 33 + (lane & 31)] = W[(size_t)(k0 + kk) * ldw + n0 + (lane & 31)]; }
    LDS_WAIT(); asm volatile("" ::: "memory");
    const int c = lane & 7;
    f32x4 g0 = {1.f, 1.f, 1.f, 1.f}, g1 = {1.f, 1.f, 1.f, 1.f};
    if (gain) { g0 = *(const f32x4*)(gain + k0 + 8 * c); g1 = *(const f32x4*)(gain + k0 + 8 * c + 4); }
#pragma unroll
    for (int j = 0; j < 4; ++j) { const int n = (lane >> 3) + 8 * j; const LAS float* s = scr + (8 * c) * 33 + n;
        u32x4 o; o.x = cvt_pk_bf16(s[0 * 33] * g0.x, s[1 * 33] * g0.y); o.y = cvt_pk_bf16(s[2 * 33] * g0.z, s[3 * 33] * g0.w); o.z = cvt_pk_bf16(s[4 * 33] * g1.x, s[5 * 33] * g1.y); o.w = cvt_pk_bf16(s[6 * 33] * g1.z, s[7 * 33] * g1.w);
        *(u32x4*)(WT + (size_t)(n0 + n) * ldo + k0 + 8 * c) = o; }
    LDS_WAIT(); asm volatile("" ::: "memory");
}
__device__ __forceinline__ bool p0_mat(int& r, const float* W, int K, int N, bf16_t* WT, LAS float* scr, int lane) {
    const int nblk = N / 32, cnt = (K / 64) * nblk;
    if (r < cnt) { p0_transpose_item(W, N, WT, K, 64 * (r / nblk), 32 * (r % nblk), scr, lane); return true; }
    r -= cnt; return false;
}

constexpr int CW_BG = 64;
constexpr int BG_I_OUTE = (D / 64) * (D / 32), BG_I_UP = (D / 64) * (FF / 32), BG_I_DN = (FF / 64) * (D / 32), BG_I_INO = (D / 64) * (OIN / 32), BG_I_G = 16 * 2 * 50, BG_I_OUTO = (DR / 64) * (D / 32);
constexpr int BG_E1 = BG_I_OUTE / 16;
constexpr int BG_E2 = BG_E1 + BG_I_UP / 16;
constexpr int BG_E3 = BG_E2 + BG_I_DN / 16;
constexpr int BG_E4 = BG_E3 + BG_I_INO / 16;
constexpr int BG_E5 = BG_E4 + BG_I_G / 16;
constexpr int BG_E6 = BG_E5 + BG_I_OUTO / 16;
constexpr int BG_E7 = BG_E6 + BG_I_UP / 16;
constexpr int BG_E8 = BG_E7 + BG_I_DN / 16;
constexpr unsigned BG_NONE = 0xffffffffu;
typedef __attribute__((address_space(4))) const unsigned char* kargp2_t;
__device__ __forceinline__ const float* bg_in(int i) { kargp2_t kp = (kargp2_t)__builtin_amdgcn_kernarg_segment_ptr(); asm volatile("" : "+s"(kp)); return *(const float* const __attribute__((address_space(4)))*)(kp + 8 * i); }
__device__ __forceinline__ unsigned char* bg_ws() { kargp2_t kp = (kargp2_t)__builtin_amdgcn_kernarg_segment_ptr(); asm volatile("" : "+s"(kp)); return *(unsigned char* const __attribute__((address_space(4)))*)(kp + 208); }
struct BgItem { const float* W; bf16_t* WT; const float* gain; int ldw, ldo, k0, n0, perm; };
__device__ __forceinline__ BgItem bg_decode(int r, unsigned char* ws) {
    const float* W; bf16_t* WT; int K, N; const float* gain = nullptr;
    if (r < BG_I_OUTE) { W = bg_in(13); WT = (bf16_t*)(ws + WS_WOUTE); K = D; N = D; }
    else if ((r -= BG_I_OUTE) < BG_I_UP) { W = bg_in(23); WT = (bf16_t*)(ws + WS_WUP); K = D; N = FF; gain = bg_in(7); }
    else if ((r -= BG_I_UP) < BG_I_DN) { W = bg_in(24); WT = (bf16_t*)(ws + WS_WDN); K = FF; N = D; }
    else if ((r -= BG_I_DN) < BG_I_INO) { W = bg_in(14); WT = (bf16_t*)(ws + WS_WINO); K = D; N = OIN; gain = bg_in(6) + D; }
    else if ((r -= BG_I_INO) < BG_I_G) { const int blk = r / 100, rr = r % 100, gate = rr / 50, q = rr % 50;
        W = (gate ? bg_in(19) : bg_in(17)) + (size_t)blk * 320 * 320; WT = (bf16_t*)(ws + WS_GW) + (size_t)(blk * GWN) * GWK; K = -1 - gate; N = 320; r = q; }
    else if ((r -= BG_I_G) < BG_I_OUTO) { W = bg_in(22); WT = (bf16_t*)(ws + WS_WOUTO); K = DR; N = D; }
    else if ((r -= BG_I_OUTO) < BG_I_UP) { W = bg_in(23) + (size_t)D * FF; WT = (bf16_t*)(ws + WS_WUP) + (size_t)D * FF; K = D; N = FF; gain = bg_in(7) + D; }
    else { r -= BG_I_UP; W = bg_in(24) + (size_t)D * FF; WT = (bf16_t*)(ws + WS_WDN) + (size_t)D * FF; K = FF; N = D; }
    BgItem it; it.W = W; it.WT = WT; it.gain = gain; it.ldw = N; it.perm = K < 0 ? -K : 0;
    if (K < 0) { it.ldo = GWK; it.k0 = 64 * (r / 10); it.n0 = 32 * (r % 10); } else { const int nblk = N / 32; it.ldo = K; it.k0 = 64 * (r / nblk); it.n0 = 32 * (r % nblk); }
    return it;
}
__device__ __forceinline__ void bg_load(f32x4 (&v)[8], const BgItem& it, int lane) {
#pragma unroll
    for (int i = 0; i < 8; ++i) v[i] = __builtin_nontemporal_load((const f32x4*)(it.W + (size_t)(it.k0 + 8 * i + (lane >> 3)) * it.ldw + it.n0 + 4 * (lane & 7)));
}
template <bool NT> __device__ __forceinline__ void bg_finish(const f32x4 (&v)[8], const BgItem& it, LAS float* scr, int lane) {
#pragma unroll
    for (int i = 0; i < 8; ++i) { LAS float* d = scr + (8 * i + (lane >> 3)) * 33 + 4 * (lane & 7); d[0] = v[i].x; d[1] = v[i].y; d[2] = v[i].z; d[3] = v[i].w; }
    LDS_WAIT(); asm volatile("" ::: "memory");
    const int c = lane & 7;
    f32x4 g0 = {1.f, 1.f, 1.f, 1.f}, g1 = {1.f, 1.f, 1.f, 1.f};
    if (it.gain) { g0 = *(const f32x4*)(it.gain + it.k0 + 8 * c); g1 = *(const f32x4*)(it.gain + it.k0 + 8 * c + 4); }
#pragma unroll
    for (int j = 0; j < 4; ++j) { const int n = (lane >> 3) + 8 * j; const LAS float* sp = scr + (8 * c) * 33 + n;
        u32x4 o; o.x = cvt_pk_bf16(sp[0 * 33] * g0.x, sp[1 * 33] * g0.y); o.y = cvt_pk_bf16(sp[2 * 33] * g0.z, sp[3 * 33] * g0.w); o.z = cvt_pk_bf16(sp[4 * 33] * g1.x, sp[5 * 33] * g1.y); o.w = cvt_pk_bf16(sp[6 * 33] * g1.z, sp[7 * 33] * g1.w);
        const int nn_ = it.n0 + n;
        if (it.perm) {
            const int orow = 16 * (nn_ >> 3) + 4 * ((nn_ & 7) >> 1) + 2 * (it.perm - 1) + (nn_ & 1); const int kc = (it.k0 >> 3) + c;
            *(u32x4*)(it.WT + ((size_t)((orow >> 4) * 10 + (kc >> 2)) * 64 + (kc & 3) * 16 + (orow & 15)) * 8) = o; }
        else if (NT) __builtin_nontemporal_store(o, (u32x4*)(it.WT + (size_t)nn_ * it.ldo + it.k0 + 8 * c));
        else *(u32x4*)(it.WT + (size_t)nn_ * it.ldo + it.k0 + 8 * c) = o; }
    LDS_WAIT(); asm volatile("" ::: "memory");
}
__device__ __forceinline__ void bg_process(unsigned batch, LAS unsigned char* lds) {
    const int t_ = tid_l(); const int wave = __builtin_amdgcn_readfirstlane(t_ >> 6), lane = t_ & 63;
    LAS float* scr = (LAS float*)(lds + wave * 16384);
    unsigned char* ws = bg_ws();
    const int r0 = (int)batch * 16 + wave * 2;
    const BgItem a = bg_decode(r0, ws), b = bg_decode(r0 + 1, ws);
    f32x4 va[8], vb[8];
    bg_load(va, a, lane); bg_load(vb, b, lane);
    bg_finish<true>(va, a, scr, lane);
    bg_finish<true>(vb, b, scr, lane);
}
__device__ __forceinline__ unsigned bg_claim(unsigned* ctl, unsigned upto) {
    if (upto < (unsigned)BG_E8 && xb_ld(ctl + CW_BG) >= upto) return BG_NONE;
    const unsigned b = xb_add(ctl + CW_BG, 1u); return b < (unsigned)BG_E8 ? b : BG_NONE;
}
__device__ __forceinline__ void bg_drain(unsigned* ctl, unsigned deadline, LAS unsigned char* lds, volatile LAS unsigned* W5) {
    for (;;) {
        if (threadIdx.x == 0) W5[5] = bg_claim(ctl, deadline);
        __syncthreads();
        const unsigned bb = W5[5];
        if (bb == BG_NONE) break;
        bg_process(bb, lds);
        __syncthreads();
    }
    __syncthreads();
}
__device__ __forceinline__ void xcd_barrier_bg(const XcdBarrier& b, unsigned* ctl, LAS unsigned char* lds, volatile LAS unsigned* W5) {
    asm volatile("s_waitcnt vmcnt(0)" ::: "memory");
    __syncthreads();
    if (threadIdx.x == 0) {
        unsigned* bar = b.bar;
        __builtin_amdgcn_s_waitcnt(0);
        unsigned nloc = b.st[0], nx = b.st[1];
        if (nloc == 0u) { xcd_barrier_complete(bar, b.x, nloc, nx); b.st[0] = nloc; b.st[1] = nx; }
        const unsigned old = xb_add(&bar[XB_XSUB(b.x)], 1u);
        const unsigned gen = old / nloc;
        unsigned leader = 0u, tg = 0u, lastx = 0u;
        if (old + 1u == (gen + 1u) * nloc) {
            leader = 1u;
            __builtin_amdgcn_fence(__ATOMIC_RELEASE, "agent");
            asm volatile("s_waitcnt vmcnt(0)" ::: "memory");
            const unsigned og = xb_add(&bar[XB_TOP], 1u);
            tg = og / nx;
            if (og + 1u == (tg + 1u) * nx) { xb_add(&bar[XB_TOPGEN], 1u); lastx = 1u; }
        }
        W5[0] = leader; W5[1] = gen; W5[2] = tg; W5[3] = lastx;
    }
    __syncthreads();
    const unsigned leader = W5[0], gen = W5[1], tg = W5[2], lastx = W5[3];
    for (unsigned it = 0;; ++it) {
        if (threadIdx.x == 0) {
            unsigned* bar = b.bar;
            bool done = leader ? (lastx != 0u || xb_ld(&bar[XB_TOPGEN]) != tg) : (xb_ld(&bar[XB_XGEN(b.x)]) != gen);
            if (!done && (it & 255u) == 255u) { if (xb_ld(&bar[XB_TMO])) done = true; else if (it > XB_SPIN_CAP) { atomicAdd(&bar[XB_TMO], 1u); done = true; } }
            W5[4] = done ? 1u : 0u;
            unsigned cl = BG_NONE;
            if (!done && !leader && W5[6] == 0u) { cl = bg_claim(ctl, (unsigned)BG_E8); if (cl == BG_NONE) W5[6] = 1u; }
            W5[5] = cl;
        }
        __syncthreads();
        if (W5[4]) break;
        const unsigned bb = W5[5];
        if (bb != BG_NONE) bg_process(bb, lds); else __builtin_amdgcn_s_sleep(8);
        __syncthreads();
    }
    if (threadIdx.x == 0) {
        unsigned* bar = b.bar;
        __builtin_amdgcn_fence(__ATOMIC_ACQUIRE, "agent");
        if (leader) xb_add(&bar[XB_XGEN(b.x)], 1u);
        asm volatile("s_waitcnt vmcnt(0)" ::: "memory");
    }
    __syncthreads();
}

template <bool FINAL> __device__ __forceinline__ void rms_phase(const float* srcP, const float* srcS, const float* part, float* hout, const float* gain, bf16_t* XN, float* outf, int gw, int NGW, int lane) {
    f32x4 g4v[16];
#pragma unroll
    for (int j = 0; j < 16; ++j) g4v[j] = ((const f32x4*)gain)[lane + 64 * j];
    for (int m = gw; m < M; m += NGW) {
        const float* src = (m < MP) ? srcP + (size_t)m * D : srcS + (size_t)(m - MP) * D;
        const f32x4* xr = (const f32x4*)src + lane;
        f32x4 v[16]; float ss = 0.f;
#pragma unroll
        for (int j = 0; j < 16; ++j) v[j] = xr[64 * j];
        if (part != nullptr && m >= MP) {
#pragma unroll
            for (int g = 0; g < 4; ++g) { const f32x4* pr = (const f32x4*)(part + ((size_t)g * MS + (m - MP)) * D) + lane;
#pragma unroll
                for (int j = 0; j < 16; ++j) v[j] += pr[64 * j]; }
            if (hout != nullptr) {
#pragma unroll
                for (int j = 0; j < 16; ++j) ((f32x4*)(hout + (size_t)m * D))[lane + 64 * j] = v[j]; }
        }
#pragma unroll
        for (int j = 0; j < 16; ++j) ss += (v[j].x * v[j].x + v[j].y * v[j].y) + (v[j].z * v[j].z + v[j].w * v[j].w);
        ss = wave_sum(ss);
        const float rstd = __builtin_amdgcn_rsqf(ss * (1.0f / D) + EPS);
#pragma unroll
        for (int j = 0; j < 16; ++j) { const f32x4 o = v[j] * rstd * g4v[j];
            if (FINAL) __builtin_nontemporal_store(o, (f32x4*)(outf + (size_t)m * D) + lane + 64 * j);
            else { u32x2 w; w.x = cvt_pk_bf16(o.x, o.y); w.y = cvt_pk_bf16(o.z, o.w); ((u32x2*)(XN + (size_t)m * D))[lane + 64 * j] = w; } }
    }
}

__device__ __forceinline__ void mini_norm_phase(const float* xs, const bf16_t* part, bf16_t* HB, const float* SSP, float* RSTD, int gw, int NGW, int lane, int vcu, int G, int tid) {
    for (int m = MP + gw; m < M; m += NGW) {
        f32x4 v[16]; float ss = 0.f;
        if (xs) { const f32x4* xr = (const f32x4*)(xs + (size_t)(m - MP) * D) + lane;
#pragma unroll
            for (int j = 0; j < 16; ++j) v[j] = xr[64 * j]; }
        else { const u32x2* hr = (const u32x2*)(HB + (size_t)m * D) + lane;
#pragma unroll
            for (int j = 0; j < 16; ++j) { const u32x2 w = hr[64 * j]; v[j] = (f32x4){bflo(w.x), bfhi(w.x), bflo(w.y), bfhi(w.y)}; } }
#pragma unroll
        for (int g = 0; g < 4; ++g) { const u32x2* pr = (const u32x2*)(part + ((size_t)g * MS + (m - MP)) * D) + lane;
#pragma unroll
            for (int j = 0; j < 16; ++j) { const u32x2 q = pr[64 * j]; v[j] += (f32x4){bflo(q.x), bfhi(q.x), bflo(q.y), bfhi(q.y)}; } }
#pragma unroll
        for (int j = 0; j < 16; ++j) { u32x2 w; w.x = cvt_pk_bf16(v[j].x, v[j].y); w.y = cvt_pk_bf16(v[j].z, v[j].w); ((u32x2*)(HB + (size_t)m * D))[lane + 64 * j] = w;
            const float r0 = bflo(w.x), r1 = bfhi(w.x), r2 = bflo(w.y), r3 = bfhi(w.y); ss += (r0 * r0 + r1 * r1) + (r2 * r2 + r3 * r3); }
        ss = wave_sum(ss);
        if (lane == 0) RSTD[m] = __builtin_amdgcn_rsqf(ss * (1.0f / D) + EPS);
    }
    for (int r = vcu * 512 + tid; r < MP; r += G * 512) { const f32x4* sp = (const f32x4*)(SSP + (size_t)r * 64); float ss = 0.f;
#pragma unroll
        for (int j = 0; j < 16; ++j) { const f32x4 q = sp[j]; ss += (q.x + q.y) + (q.z + q.w); }
        RSTD[r] = __builtin_amdgcn_rsqf(ss * (1.0f / D) + EPS); }
}
__device__ __forceinline__ void final_norm_phase(const bf16_t* HB, const bf16_t* part, const float* gain, float* outf, int gw, int NGW, int lane) {
    f32x4 g4v[16];
#pragma unroll
    for (int j = 0; j < 16; ++j) g4v[j] = ((const f32x4*)gain)[lane + 64 * j];
    for (int m = gw; m < M; m += NGW) {
        const u32x2* hr = (const u32x2*)(HB + (size_t)m * D) + lane; f32x4 v[16]; float ss = 0.f;
#pragma unroll
        for (int j = 0; j < 16; ++j) { const u32x2 w = hr[64 * j]; v[j] = (f32x4){bflo(w.x), bfhi(w.x), bflo(w.y), bfhi(w.y)}; }
        if (m >= MP) {
#pragma unroll
            for (int g = 0; g < 4; ++g) { const u32x2* pr = (const u32x2*)(part + ((size_t)g * MS + (m - MP)) * D) + lane;
#pragma unroll
                for (int j = 0; j < 16; ++j) { const u32x2 q = pr[64 * j]; v[j] += (f32x4){bflo(q.x), bfhi(q.x), bflo(q.y), bfhi(q.y)}; } } }
#pragma unroll
        for (int j = 0; j < 16; ++j) ss += (v[j].x * v[j].x + v[j].y * v[j].y) + (v[j].z * v[j].z + v[j].w * v[j].w);
        ss = wave_sum(ss);
        const float rstd = __builtin_amdgcn_rsqf(ss * (1.0f / D) + EPS);
#pragma unroll
        for (int j = 0; j < 16; ++j) __builtin_nontemporal_store(v[j] * rstd * g4v[j], (f32x4*)(outf + (size_t)m * D) + lane + 64 * j);
    }
}

namespace mix {
typedef short s16x4 __attribute__((ext_vector_type(4)));
typedef short s16x8 __attribute__((ext_vector_type(8)));
constexpr int PQ = 136, PV = 72, PVR = 40, PLF = 132;
constexpr int OFF_LF = 0;
constexpr int OFF_SEG = 33792;
constexpr int IMG_Q = 0, IMG_K = 17408, IMG_V = 34816, IMG_D = 39936, IMG_BYTES = 40448;
constexpr int OFF_IMG = 0;
constexpr int OFF_ATT = OFF_IMG + 2 * IMG_BYTES;
constexpr int OFF_ST = OFF_ATT + 2 * 9216;
constexpr int OFF_END = OFF_ST + 2 * 8704;
static_assert(OFF_END <= RING_BYTES && OFF_SEG + 2048 <= RING_BYTES, "mixer LDS");
constexpr int NCHUNK = 2 * (SEQ / 64) + DECB;

struct Raw { u32x4 q0, q1, f0, f1; f32x4 rc[4]; };
__device__ __forceinline__ void prep_decode(int u, int& row0, int& L, int& pos0, int& hd, int& cidx) {
    cidx = u / 24; hd = u % 24;
    if (cidx < 256) { row0 = cidx * 64; L = 64; pos0 = (cidx & 127) * 64; } else { row0 = MP + (cidx - 256) * DECS; L = DECS; pos0 = PAST; }
}
__device__ __forceinline__ void prep_load(Raw& r, const bf16_t* PROJ, const f32x2* ROT, int row0, int L, int pos0, int hd, int el, int kc) {
    const int qcol = hd < 16 ? hd * 128 : 8192 + (hd - 16) * 128, fcol = hd < 16 ? 2048 + hd * 128 : 9216 + (hd - 16) * 128;
    const u32x4 z4 = {0u, 0u, 0u, 0u};
    if (el < L) { const bf16_t* prow = PROJ + (size_t)(row0 + el) * EIN;
        r.q0 = *(const u32x4*)(prow + qcol + kc); r.q1 = *(const u32x4*)(prow + qcol + 64 + kc); r.f0 = *(const u32x4*)(prow + fcol + kc); r.f1 = *(const u32x4*)(prow + fcol + 64 + kc);
        if (hd >= 16) { const f32x4* rp = (const f32x4*)(ROT + (size_t)(pos0 + el) * 64 + kc); r.rc[0] = rp[0]; r.rc[1] = rp[1]; r.rc[2] = rp[2]; r.rc[3] = rp[3]; } }
    else { r.q0 = z4; r.q1 = z4; r.f0 = z4; r.f1 = z4; }
}
__device__ __forceinline__ u32x4 pack8(const float* x) { u32x4 w; w.x = cvt_pk_bf16(x[0], x[1]); w.y = cvt_pk_bf16(x[2], x[3]); w.z = cvt_pk_bf16(x[4], x[5]); w.w = cvt_pk_bf16(x[6], x[7]); return w; }
__device__ __forceinline__ void sig2(float x, float& s, float& ns) { const float e = fexp(-fabsf(x)), r = frcp(1.0f + e), t = e * r; s = x >= 0.f ? r : t; ns = x >= 0.f ? t : r; }
__device__ __forceinline__ void prep_unit(LAS unsigned char* lds, const Raw& r, bf16_t* PROJ, const float* LB, float* DECB, int row0, int L, int hd, int cidx, int tid) {
    const int el = tid >> 3, kc = (tid & 7) * 8; const bool valid = el < L;
    const unsigned qw[8] = {r.q0.x, r.q0.y, r.q0.z, r.q0.w, r.q1.x, r.q1.y, r.q1.z, r.q1.w};
    const unsigned fw[8] = {r.f0.x, r.f0.y, r.f0.z, r.f0.w, r.f1.x, r.f1.y, r.f1.z, r.f1.w};
    float qs[16], om[16];
    if (hd < 16) {
        LAS float* LF = (LAS float*)(lds + OFF_LF); LAS float* SEG = (LAS float*)(lds + OFF_SEG);
        const int qcol = hd * 128, fcol = 2048 + hd * 128;
        float lf[16];
#pragma unroll
        for (int i = 0; i < 8; ++i)
#pragma unroll
            for (int hh = 0; hh < 2; ++hh) { const int e = 2 * i + hh; const float q = hh ? bfhi(qw[i]) : bflo(qw[i]); const float fraw = hh ? bfhi(fw[i]) : bflo(fw[i]);
                const float lb = LB[hd * 128 + (e >> 3) * 64 + kc + (e & 7)];
                float sg, nsg, sq, nsq; sig2(fraw, sg, nsg); sig2(q, sq, nsq);
                const float f = lb + (1.0f - lb) * sg;
                lf[e] = valid ? flog(f) : 0.f; om[e] = (1.0f - lb) * nsg; qs[e] = q * sq; }
#pragma unroll
        for (int c = 0; c < 2; ++c) { *(LAS f32x4*)(LF + el * PLF + c * 64 + kc) = (f32x4){lf[c * 8 + 0], lf[c * 8 + 1], lf[c * 8 + 2], lf[c * 8 + 3]};
            *(LAS f32x4*)(LF + el * PLF + c * 64 + kc + 4) = (f32x4){lf[c * 8 + 4], lf[c * 8 + 5], lf[c * 8 + 6], lf[c * 8 + 7]}; }
        __syncthreads();
        { const int k = tid & 127, sg = tid >> 7; float run = 0.f;
#pragma unroll
          for (int i = 0; i < 16; ++i) { run += LF[(sg * 16 + i) * PLF + k]; LF[(sg * 16 + i) * PLF + k] = run; }
          SEG[sg * 128 + k] = run; }
        __syncthreads();
        if (tid < 128) DECB[(size_t)(cidx * 16 + hd) * 128 + tid] = fexp((SEG[tid] + SEG[128 + tid]) + (SEG[256 + tid] + SEG[384 + tid]));
        const int sgl = el >> 4;
        if (valid) {
            bf16_t* prow = PROJ + (size_t)(row0 + el) * EIN;
#pragma unroll
            for (int c = 0; c < 2; ++c) {
                float bb[8];
#pragma unroll
                for (int j4 = 0; j4 < 2; ++j4) { const int k = c * 64 + kc + 4 * j4; f32x4 b = *(const LAS f32x4*)(LF + el * PLF + k);
                    const f32x4 s0 = *(const LAS f32x4*)(SEG + k), s1 = *(const LAS f32x4*)(SEG + 128 + k), s2 = *(const LAS f32x4*)(SEG + 256 + k);
                    if (sgl > 0) b += s0; if (sgl > 1) b += s1; if (sgl > 2) b += s2;
                    bb[4 * j4 + 0] = b.x; bb[4 * j4 + 1] = b.y; bb[4 * j4 + 2] = b.z; bb[4 * j4 + 3] = b.w; }
                float qi[8], ki[8];
#pragma unroll
                for (int j = 0; j < 8; ++j) { qi[j] = qs[c * 8 + j] * fexp(bb[j]); ki[j] = om[c * 8 + j] * fexp(-bb[j]); }
                *(u32x4*)(prow + qcol + c * 64 + kc) = pack8(qi); *(u32x4*)(prow + fcol + c * 64 + kc) = pack8(ki); }
        }
        __syncthreads();
    } else if (valid) {
        const int h = hd - 16; const int qcol = 8192 + h * 128, fcol = 9216 + h * 128;
        const float lg = flog(1.0f - __builtin_amdgcn_exp2f(-5.0f - (float)h));
        const float cs[16] = {r.rc[0].x, r.rc[0].y, r.rc[0].z, r.rc[0].w, r.rc[1].x, r.rc[1].y, r.rc[1].z, r.rc[1].w, r.rc[2].x, r.rc[2].y, r.rc[2].z, r.rc[2].w, r.rc[3].x, r.rc[3].y, r.rc[3].z, r.rc[3].w};
        const float e1 = fexp((float)(el + 1) * lg), e2 = fexp(-(float)(el + 1) * lg) * 0.08838834764831845f;
#pragma unroll
        for (int i = 0; i < 4; ++i)
#pragma unroll
            for (int hh = 0; hh < 2; ++hh) { const int j = 2 * i + hh; const float co = cs[2 * j], si = cs[2 * j + 1];
                const float q1 = hh ? bfhi(qw[i]) : bflo(qw[i]), q2 = hh ? bfhi(qw[4 + i]) : bflo(qw[4 + i]);
                const float k1 = hh ? bfhi(fw[i]) : bflo(fw[i]), k2 = hh ? bfhi(fw[4 + i]) : bflo(fw[4 + i]);
                qs[j] = (q1 * co - q2 * si) * e1; qs[8 + j] = (q2 * co + q1 * si) * e1; om[j] = (k1 * co - k2 * si) * e2; om[8 + j] = (k2 * co + k1 * si) * e2; }
        bf16_t* prow = PROJ + (size_t)(row0 + el) * EIN;
#pragma unroll
        for (int c = 0; c < 2; ++c) { *(u32x4*)(prow + qcol + c * 64 + kc) = pack8(qs + c * 8); *(u32x4*)(prow + fcol + c * 64 + kc) = pack8(om + c * 8); }
    }
}

struct RawC { u32x4 q0, q1, f0, f1, v; float d; };
template <int KIND, bool SAMPLE>
__device__ __forceinline__ void chain(LAS unsigned char* lds, const bf16_t* PROJ, bf16_t* ORAW, const float* DECB,
                                      int row0, int nsteps, int cidx0, int sb0, int sbs, int h, int vs, const float* S0b, float* Sob) {
    constexpr int DV = KIND == 0 ? 128 : 256; constexpr size_t sstride = (size_t)128 * DV * (KIND == 0 ? 16 : 8);
    constexpr int L = SAMPLE ? DECS : 64;
    const int tid = tid_l(), wid = __builtin_amdgcn_readfirstlane(tid >> 6), lane = tid & 63, fr = lane & 15, fq = lane >> 4;
    const int qcol = KIND == 0 ? h * 128 : 8192 + h * 128;
    const int fcol = KIND == 0 ? 2048 + h * 128 : 9216 + h * 128;
    const int vcol = KIND == 0 ? 4096 + h * 128 + vs * 32 : 10240 + h * 256 + vs * 32;
    const int ocol = KIND == 0 ? h * 128 + vs * 32 : 2048 + h * 256 + vs * 32;
    const size_t hoff = (size_t)h * 128 * DV;
    const int el = tid >> 3, kc = (tid & 7) * 8;
    const bool valid = el < L;
    const int vl = tid >> 2, vq = tid & 3;
    const bool vvalid = (tid < 256) && (vl < L);
    float decc = 1.f;
    if (KIND == 1) decc = fexp((float)L * flog(1.0f - __builtin_amdgcn_exp2f(-5.0f - (float)h)));
    const u32x4 z4 = {0u, 0u, 0u, 0u};
#define CH_ROW(s) (SAMPLE ? MP + (sb0 + sbs * (s)) * DECS : row0 + (s) * 64)
#define CH_LOAD(R, s) do { const int rb_ = CH_ROW(s); const bf16_t* prow = PROJ + (size_t)(rb_ + el) * EIN; \
        if (valid) { R.q0 = *(const u32x4*)(prow + qcol + kc); R.q1 = *(const u32x4*)(prow + qcol + 64 + kc); R.f0 = *(const u32x4*)(prow + fcol + kc); R.f1 = *(const u32x4*)(prow + fcol + 64 + kc); } \
        else { R.q0 = z4; R.q1 = z4; R.f0 = z4; R.f1 = z4; } \
        if (vvalid) R.v = *(const u32x4*)(PROJ + (size_t)(rb_ + vl) * EIN + vcol + vq * 8); else R.v = z4; \
        R.d = 1.f; if (KIND == 0 && tid < 128) R.d = DECB[(size_t)((SAMPLE ? 256 + sb0 + sbs * (s) : cidx0 + (s)) * 16 + h) * 128 + tid]; } while (0)
#define CH_IMAGE(R, b) do { LAS unsigned char* im_ = lds + OFF_IMG + (b) * IMG_BYTES; \
        if (!SAMPLE || valid) { *(LAS u32x4*)(im_ + IMG_Q + (el * PQ + kc) * 2) = R.q0; *(LAS u32x4*)(im_ + IMG_Q + (el * PQ + 64 + kc) * 2) = R.q1; \
        *(LAS u32x4*)(im_ + IMG_K + (el * PQ + kc) * 2) = R.f0; *(LAS u32x4*)(im_ + IMG_K + (el * PQ + 64 + kc) * 2) = R.f1; } \
        if (tid < 128) ((LAS float*)(im_ + IMG_D))[tid] = KIND == 0 ? R.d : decc; \
        if (tid < 256 && (!SAMPLE || vl < L)) *(LAS u32x4*)(im_ + IMG_V + (vl * PVR + vq * 8) * 2) = R.v; } while (0)
    f32x4 sacc[2], snx[2];
#define CH_STATE_LOAD(dst, s) do { const float* sp_ = S0b + (size_t)(sb0 + sbs * (s)) * sstride + hoff; \
        _Pragma("unroll") for (int vt = 0; vt < 2; ++vt) _Pragma("unroll") for (int r = 0; r < 4; ++r) dst[vt][r] = sp_[(size_t)(wid * 16 + 4 * fq + r) * DV + vs * 32 + vt * 16 + fr]; } while (0)
#define CH_ST_WRITE(buf) do { _Pragma("unroll") for (int vt = 0; vt < 2; ++vt) { u32x2 w; w.x = cvt_pk_bf16(sacc[vt][0], sacc[vt][1]); w.y = cvt_pk_bf16(sacc[vt][2], sacc[vt][3]); \
        *(LAS u32x2*)(lds + OFF_ST + (buf) * 8704 + ((vt * 16 + fr) * PQ + wid * 16 + 4 * fq) * 2) = w; } } while (0)
    if (SAMPLE) { CH_STATE_LOAD(sacc, 0); } else { sacc[0] = (f32x4){0.f, 0.f, 0.f, 0.f}; sacc[1] = sacc[0]; }
    struct Frag { bf16x8 kof[2], vfr[2][2], qfr[4]; f32x4 dec; };
    auto prep = [&](const int s1, Frag& F) __attribute__((always_inline)) {
        LAS unsigned char* im = lds + OFF_IMG + (s1 & 1) * IMG_BYTES;
        const LAS bf16_t* QIN = (const LAS bf16_t*)(im + IMG_Q); const LAS bf16_t* KIN = (const LAS bf16_t*)(im + IMG_K); const LAS bf16_t* VR = (const LAS bf16_t*)(im + IMG_V); const LAS float* DEC = (const LAS float*)(im + IMG_D);
        LAS bf16_t* ATT = (LAS bf16_t*)(lds + OFF_ATT + (s1 & 1) * 9216);
        { const int q = fr >> 2, p = fr & 3;
#pragma unroll
          for (int ll = 0; ll < (SAMPLE ? 1 : 2); ++ll) {
            const s16x4 lo = __builtin_amdgcn_ds_read_tr16_b64_v4i16((LAS s16x4*)(KIN + (32 * ll + 8 * fq + q) * PQ + wid * 16 + 4 * p));
            const s16x4 hi = __builtin_amdgcn_ds_read_tr16_b64_v4i16((LAS s16x4*)(KIN + (32 * ll + 8 * fq + 4 + q) * PQ + wid * 16 + 4 * p));
            const s16x8 w = {lo[0], lo[1], lo[2], lo[3], hi[0], hi[1], hi[2], hi[3]};
            F.kof[ll] = __builtin_bit_cast(bf16x8, w);
#pragma unroll
            for (int vt = 0; vt < 2; ++vt) {
              const s16x4 vlo = __builtin_amdgcn_ds_read_tr16_b64_v4i16((LAS s16x4*)(VR + (32 * ll + 8 * fq + q) * PVR + vt * 16 + 4 * p));
              const s16x4 vhi = __builtin_amdgcn_ds_read_tr16_b64_v4i16((LAS s16x4*)(VR + (32 * ll + 8 * fq + 4 + q) * PVR + vt * 16 + 4 * p));
              const s16x8 vw = {vlo[0], vlo[1], vlo[2], vlo[3], vhi[0], vhi[1], vhi[2], vhi[3]};
              F.vfr[vt][ll] = __builtin_bit_cast(bf16x8, vw); } } }
        F.dec = *(const LAS f32x4*)(DEC + wid * 16 + 4 * fq);
        const int lt = wid & 3, hi = wid >> 2;
        const int mtA = hi ? (lt == 1 ? 1 : 2) : 0, mtB = hi ? 3 : 1;
        const bool live = !(SAMPLE && lt >= 2);
        const bool hasA = live && !(hi && lt == 0), hasB = live && (hi ? (lt == 3) : (lt >= 2));
        if (live)
#pragma unroll
        for (int kk = 0; kk < 4; ++kk) F.qfr[kk] = *(const LAS bf16x8*)(QIN + (lt * 16 + fr) * PQ + kk * 32 + 8 * fq);
        const int l = lt * 16 + fr;
        if (hasA) { f32x4 d = {0.f, 0.f, 0.f, 0.f};
#pragma unroll
            for (int kk = 0; kk < 4; ++kk) { const bf16x8 a = *(const LAS bf16x8*)(KIN + (mtA * 16 + fr) * PQ + kk * 32 + 8 * fq); d = __builtin_amdgcn_mfma_f32_16x16x32_bf16(a, F.qfr[kk], d, 0, 0, 0); }
            const int m0 = mtA * 16 + 4 * fq; float x[4];
#pragma unroll
            for (int r = 0; r < 4; ++r) x[r] = (m0 + r <= l) ? d[r] : 0.f;
            u32x2 w; w.x = cvt_pk_bf16(x[0], x[1]); w.y = cvt_pk_bf16(x[2], x[3]); *(LAS u32x2*)(ATT + l * PV + m0) = w; }
        if (hasB) { f32x4 d = {0.f, 0.f, 0.f, 0.f};
#pragma unroll
            for (int kk = 0; kk < 4; ++kk) { const bf16x8 a = *(const LAS bf16x8*)(KIN + (mtB * 16 + fr) * PQ + kk * 32 + 8 * fq); d = __builtin_amdgcn_mfma_f32_16x16x32_bf16(a, F.qfr[kk], d, 0, 0, 0); }
            const int m0 = mtB * 16 + 4 * fq; float x[4];
#pragma unroll
            for (int r = 0; r < 4; ++r) x[r] = (m0 + r <= l) ? d[r] : 0.f;
            u32x2 w; w.x = cvt_pk_bf16(x[0], x[1]); w.y = cvt_pk_bf16(x[2], x[3]); *(LAS u32x2*)(ATT + l * PV + m0) = w; }
    };
    auto interval = [&](const int s, Frag& Fc, Frag& Fn, RawC& R) __attribute__((always_inline)) {
        if (!(SAMPLE && (wid & 3) >= 2)) {
            const int vt = wid >> 2, lt = wid & 3; const int v = vt * 16 + fr;
            const LAS bf16_t* ATT = (const LAS bf16_t*)(lds + OFF_ATT + (s & 1) * 9216);
            f32x4 d = {0.f, 0.f, 0.f, 0.f};
#pragma unroll
            for (int mm = 0; mm < 2; ++mm) if (mm == 0 || lt >= 2) {
                const bf16x8 a = vt ? Fc.vfr[1][mm] : Fc.vfr[0][mm];
                const bf16x8 b = *(const LAS bf16x8*)(ATT + (lt * 16 + fr) * PV + mm * 32 + 8 * fq);
                d = __builtin_amdgcn_mfma_f32_16x16x32_bf16(a, b, d, 0, 0, 0); }
            const LAS bf16_t* STc = (const LAS bf16_t*)(lds + OFF_ST + (s & 1) * 8704);
#pragma unroll
            for (int kk = 0; kk < 4; ++kk) {
                const bf16x8 a = *(const LAS bf16x8*)(STc + v * PQ + kk * 32 + 8 * fq);
                d = __builtin_amdgcn_mfma_f32_16x16x32_bf16(a, Fc.qfr[kk], d, 0, 0, 0); }
            const int l = lt * 16 + fr;
            if (l < L) { u32x2 w; w.x = cvt_pk_bf16(d[0], d[1]); w.y = cvt_pk_bf16(d[2], d[3]); *(u32x2*)(ORAW + (size_t)(CH_ROW(s) + l) * D + ocol + vt * 16 + 4 * fq) = w; }
        }
#pragma unroll
        for (int vt = 0; vt < 2; ++vt) {
#pragma unroll
            for (int ll = 0; ll < (SAMPLE ? 1 : 2); ++ll) sacc[vt] = __builtin_amdgcn_mfma_f32_16x16x32_bf16(Fc.kof[ll], Fc.vfr[vt][ll], sacc[vt], 0, 0, 0);
            sacc[vt] = sacc[vt] * Fc.dec; }
        if (SAMPLE) {
            float* so = Sob + (size_t)(sb0 + sbs * s) * sstride + hoff;
#pragma unroll
            for (int vt = 0; vt < 2; ++vt)
#pragma unroll
                for (int r = 0; r < 4; ++r) so[(size_t)(wid * 16 + 4 * fq + r) * DV + vs * 32 + vt * 16 + fr] = sacc[vt][r];
            if (s + 1 < nsteps) { sacc[0] = snx[0]; sacc[1] = snx[1]; if (s + 2 < nsteps) CH_STATE_LOAD(snx, s + 2); }
        }
        if (s + 1 < nsteps) { CH_ST_WRITE((s + 1) & 1); prep(s + 1, Fn); }
        if (s + 2 < nsteps) { CH_IMAGE(R, s & 1); if (s + 4 < nsteps) CH_LOAD(R, s + 4); }
        __syncthreads();
    };
    for (int i = tid; i < 2 * 9216 / 16; i += 512) *(LAS u32x4*)(lds + OFF_ATT + i * 16) = (u32x4){0u, 0u, 0u, 0u};
    RawC RA, RB;
    CH_LOAD(RA, 0);
    if (nsteps > 1) CH_LOAD(RB, 1);
    CH_IMAGE(RA, 0);
    if (nsteps > 1) CH_IMAGE(RB, 1);
    if (nsteps > 2) CH_LOAD(RA, 2);
    if (nsteps > 3) CH_LOAD(RB, 3);
    CH_ST_WRITE(0);
    if (SAMPLE && nsteps > 1) CH_STATE_LOAD(snx, 1);
    __syncthreads();
    Frag FA, FB;
    prep(0, FA);
    __syncthreads();
    for (int s = 0; s < nsteps; s += 2) { interval(s, FA, FB, RA); if (s + 1 < nsteps) interval(s + 1, FB, FA, RB); }
    if (!SAMPLE) {
#pragma unroll
        for (int vt = 0; vt < 2; ++vt)
#pragma unroll
            for (int r = 0; r < 4; ++r) Sob[hoff + (size_t)(wid * 16 + 4 * fq + r) * DV + vs * 32 + vt * 16 + fr] = sacc[vt][r];
    }
#undef CH_ROW
#undef CH_LOAD
#undef CH_IMAGE
#undef CH_STATE_LOAD
#undef CH_ST_WRITE
}
}

__device__ __forceinline__ void headnorm_phase(const bf16_t* ORAW, const bf16_t* PROJ, const float* gA, const float* gB, bf16_t* MIXO, int gw, int NGW, int lane) {
    f32x4 nv[8][2];
#pragma unroll
    for (int j = 0; j < 8; ++j) { const float* gn = (j < 4 ? gA : gB) + 8 * lane + 512 * (j & 3); nv[j][0] = *(const f32x4*)gn; nv[j][1] = *(const f32x4*)(gn + 4); }
    for (int m = gw; m < M; m += NGW) {
        const u32x4* orow = (const u32x4*)(ORAW + (size_t)m * D) + lane;
        const bf16_t* prow = PROJ + (size_t)m * EIN;
        u32x4* mrow = (u32x4*)(MIXO + (size_t)m * D) + lane;
#pragma unroll
        for (int j = 0; j < 8; ++j) {
            const u32x4 ow = orow[64 * j]; float o[8] = {bflo(ow.x), bfhi(ow.x), bflo(ow.y), bfhi(ow.y), bflo(ow.z), bfhi(ow.z), bflo(ow.w), bfhi(ow.w)};
            const int c = 8 * lane + 512 * (j & 3);
            const u32x4 gw4 = *(const u32x4*)(prow + (j < 4 ? 6144 : 12288) + c); const f32x4 n0 = nv[j][0], n1 = nv[j][1];
            const float g[8] = {bflo(gw4.x), bfhi(gw4.x), bflo(gw4.y), bfhi(gw4.y), bflo(gw4.z), bfhi(gw4.z), bflo(gw4.w), bfhi(gw4.w)}; const float nn[8] = {n0.x, n0.y, n0.z, n0.w, n1.x, n1.y, n1.z, n1.w};
            float rs;
            if (j < 4) { float ss = 0.f;
#pragma unroll
                for (int e = 0; e < 8; ++e) ss += o[e] * o[e];
                ss = row16_sum(ss);
                rs = __builtin_amdgcn_rsqf(ss * (1.0f / 128.0f) + EPS);
            } else { float sm = 0.f;
#pragma unroll
                for (int e = 0; e < 8; ++e) sm += o[e];
                sm = row16_sum(sm); sm += __shfl_xor(sm, 16);
                const float mu = sm * (1.0f / 256.0f); float var = 0.f;
#pragma unroll
                for (int e = 0; e < 8; ++e) { o[e] -= mu; var += o[e] * o[e]; }
                var = row16_sum(var); var += __shfl_xor(var, 16);
                rs = __builtin_amdgcn_rsqf(var * (1.0f / 256.0f) + EPS);
            }
            float r[8];
#pragma unroll
            for (int e = 0; e < 8; ++e) r[e] = o[e] * rs * nn[e] * g[e] * sigm(g[e]);
            u32x4 w; w.x = cvt_pk_bf16(r[0], r[1]); w.y = cvt_pk_bf16(r[2], r[3]); w.z = cvt_pk_bf16(r[4], r[5]); w.w = cvt_pk_bf16(r[6], r[7]);
            mrow[64 * j] = w; }
    }
}

__device__ __forceinline__ void conv_phase(const bf16_t* PROJ2, const float* sconv, const float* cw, const float* cb, bf16_t* XC, float* out, int gw, int NGW, int lane) {
    if (gw == 0) { for (int i = lane; i < 4096; i += 64) XC[(size_t)M * DR + i] = 0; }
    for (int u = gw; u < (M / 32) * 10; u += NGW) {
        const int strip = u / 10, cg = u % 10; const int r0 = strip * 32, c0 = cg * 512 + lane * 8;
        float w[4][8], bias[8], h3[8], h2[8], h1[8];
#pragma unroll
        for (int j = 0; j < 4; ++j) { const f32x4 a = *(const f32x4*)(cw + j * DR + c0), b = *(const f32x4*)(cw + j * DR + c0 + 4);
            w[j][0] = a.x; w[j][1] = a.y; w[j][2] = a.z; w[j][3] = a.w; w[j][4] = b.x; w[j][5] = b.y; w[j][6] = b.z; w[j][7] = b.w; }
        { const f32x4 a = *(const f32x4*)(cb + c0), b = *(const f32x4*)(cb + c0 + 4); bias[0] = a.x; bias[1] = a.y; bias[2] = a.z; bias[3] = a.w; bias[4] = b.x; bias[5] = b.y; bias[6] = b.z; bias[7] = b.w; }
        const bool sample = r0 >= MP; const int sb = sample ? (r0 - MP) / 32 : 0;
        const bool start = sample || (r0 % SEQ) == 0;
#pragma unroll
        for (int i = 0; i < 8; ++i) { h3[i] = 0.f; h2[i] = 0.f; h1[i] = 0.f; }
        if (start) {
            if (sample) {
                const float* sp = sconv + (size_t)sb * 3 * DR + c0;
#pragma unroll
                for (int i = 0; i < 8; ++i) { h3[i] = sp[i]; h2[i] = sp[DR + i]; h1[i] = sp[2 * DR + i]; }
            }
        } else {
            const u32x4 a = *(const u32x4*)(PROJ2 + (size_t)(r0 - 3) * OIN + c0), b = *(const u32x4*)(PROJ2 + (size_t)(r0 - 2) * OIN + c0), c = *(const u32x4*)(PROJ2 + (size_t)(r0 - 1) * OIN + c0);
            h3[0] = bflo(a.x); h3[1] = bfhi(a.x); h3[2] = bflo(a.y); h3[3] = bfhi(a.y); h3[4] = bflo(a.z); h3[5] = bfhi(a.z); h3[6] = bflo(a.w); h3[7] = bfhi(a.w);
            h2[0] = bflo(b.x); h2[1] = bfhi(b.x); h2[2] = bflo(b.y); h2[3] = bfhi(b.y); h2[4] = bflo(b.z); h2[5] = bfhi(b.z); h2[6] = bflo(b.w); h2[7] = bfhi(b.w);
            h1[0] = bflo(c.x); h1[1] = bfhi(c.x); h1[2] = bflo(c.y); h1[3] = bfhi(c.y); h1[4] = bflo(c.z); h1[5] = bfhi(c.z); h1[6] = bflo(c.w); h1[7] = bfhi(c.w);
        }
        const bool endseq = sample || ((r0 + 32) % SEQ) == 0;
        float* ocv = sample ? out + O_CVS + (size_t)sb * 3 * DR + c0 : out + O_CVP + (size_t)(r0 / SEQ) * 3 * DR + c0;
#pragma unroll 8
        for (int i = 0; i < 32; ++i) {
            const u32x4 xw = *(const u32x4*)(PROJ2 + (size_t)(r0 + i) * OIN + c0);
            float x[8] = {bflo(xw.x), bfhi(xw.x), bflo(xw.y), bfhi(xw.y), bflo(xw.z), bfhi(xw.z), bflo(xw.w), bfhi(xw.w)};
            float cv[8];
#pragma unroll
            for (int e = 0; e < 8; ++e) { cv[e] = bias[e] + w[0][e] * h3[e] + w[1][e] * h2[e] + w[2][e] * h1[e] + w[3][e] * x[e]; h3[e] = h2[e]; h2[e] = h1[e]; h1[e] = x[e]; }
            u32x4 o; o.x = cvt_pk_bf16(cv[0], cv[1]); o.y = cvt_pk_bf16(cv[2], cv[3]); o.z = cvt_pk_bf16(cv[4], cv[5]); o.w = cvt_pk_bf16(cv[6], cv[7]);
            *(u32x4*)(XC + (size_t)(r0 + i) * DR + c0) = o;
            if (endseq && i >= 29) { float* op = ocv + (size_t)(i - 29) * DR; *(f32x4*)op = (f32x4){x[0], x[1], x[2], x[3]}; *(f32x4*)(op + 4) = (f32x4){x[4], x[5], x[6], x[7]}; }
        }
    }
}
__device__ __forceinline__ float em1neg(float x) {
    if (x > -0.25f) { float p = 1.0f + x * (1.0f / 8.0f); p = 1.0f + x * (1.0f / 7.0f) * p; p = 1.0f + x * (1.0f / 6.0f) * p; p = 1.0f + x * (1.0f / 5.0f) * p; p = 1.0f + x * (1.0f / 4.0f) * p; p = 1.0f + x * (1.0f / 3.0f) * p; p = 1.0f + x * 0.5f * p; return x * p; }
    return fexp(x) - 1.0f;
}
__device__ __forceinline__ float gelu_tanh(float y) { const float z2 = (-2.0f * 0.7978845608028654f * 1.4426950408889634f) * (y + 0.044715f * y * y * y); return y * frcp(1.0f + __builtin_amdgcn_exp2f(z2)); }
template <int PASS> __device__ __forceinline__ void scan_phase(const bf16_t* PROJ2, const bf16_t* GATES, const float* SP8, const float* cw, const float* cb, const float* sconv, const float* srg,
                                                                float* AGA, float* AGH, const float* CAR, bf16_t* MIXO2, float* out, int vcu, int G, int tid) {
    const int ntiles = PASS == 1 ? 256 : 288;
    for (int u = vcu; u < ntiles * 5; u += G) {
        const int tile = u / 5, cg = u % 5; const int c = cg * 1024 + tid * 2;
        const bool sample = tile >= 256; const int sb = tile - 256;
        const int r0 = sample ? MP + sb * 32 : tile * 64; const int nrow = sample ? 32 : 64;
        const bool first = !sample && (r0 % SEQ) == 0;
        const f32x2 sp = *(const f32x2*)(SP8 + c), bias = *(const f32x2*)(cb + c);
        const f32x2 w0 = *(const f32x2*)(cw + c), w1 = *(const f32x2*)(cw + DR + c), w2 = *(const f32x2*)(cw + 2 * DR + c), w3 = *(const f32x2*)(cw + 3 * DR + c);
        f32x2 h3 = {0.f, 0.f}, h2 = {0.f, 0.f}, h1 = {0.f, 0.f};
        if (sample) { const float* s = sconv + (size_t)sb * 3 * DR + c; h3 = *(const f32x2*)s; h2 = *(const f32x2*)(s + DR); h1 = *(const f32x2*)(s + 2 * DR); }
        else if (!first) { const unsigned a = *(const unsigned*)(PROJ2 + (size_t)(r0 - 3) * OIN + c), b = *(const unsigned*)(PROJ2 + (size_t)(r0 - 2) * OIN + c), d = *(const unsigned*)(PROJ2 + (size_t)(r0 - 1) * OIN + c);
            h3 = (f32x2){bflo(a), bfhi(a)}; h2 = (f32x2){bflo(b), bfhi(b)}; h1 = (f32x2){bflo(d), bfhi(d)}; }
        f32x2 hh = {0.f, 0.f}, aa = {1.f, 1.f};
        if (PASS == 2) hh = sample ? *(const f32x2*)(srg + (size_t)sb * DR + c) : *(const f32x2*)(CAR + (size_t)tile * DR + c);
        unsigned rw[2][8], iw[2][8], xw[2][8], yw[2][8];
#define SCAN_LOAD(buf, i0_) do { _Pragma("unroll") for (int i = 0; i < 8; ++i) { const size_t ro = (size_t)(r0 + (i0_) + i) * OIN + c; rw[buf][i] = *(const unsigned*)(GATES + ro); iw[buf][i] = *(const unsigned*)(GATES + ro + DR); \
            xw[buf][i] = *(const unsigned*)(PROJ2 + ro); if (PASS == 2) yw[buf][i] = *(const unsigned*)(PROJ2 + ro + DR); else yw[buf][i] = 0u; } } while (0)
#define SCAN_COMPUTE(buf, i0_) do { _Pragma("unroll") for (int i = 0; i < 8; ++i) { \
            const f32x2 x = {bflo(xw[buf][i]), bfhi(xw[buf][i])}, r = {bflo(rw[buf][i]), bfhi(rw[buf][i])}, ig = {bflo(iw[buf][i]), bfhi(iw[buf][i])}; \
            const f32x2 cv = bias + w0 * h3 + w1 * h2 + w2 * h1 + w3 * x; h3 = h2; h2 = h1; h1 = x; \
            const float a0 = __builtin_amdgcn_exp2f(-sp.x * r.x), a1 = __builtin_amdgcn_exp2f(-sp.y * r.y); \
            float m0 = __builtin_amdgcn_sqrtf(fmaf(-a0, a0, 1.0f)), m1 = __builtin_amdgcn_sqrtf(fmaf(-a1, a1, 1.0f)); \
            if (first && ((i0_) + i) == 0) { m0 = 1.0f; m1 = 1.0f; } \
            hh.x = a0 * hh.x + m0 * ig.x * cv.x; hh.y = a1 * hh.y + m1 * ig.y * cv.y; \
            if (PASS == 1) { aa.x *= a0; aa.y *= a1; } \
            else { const float o0 = gelu_tanh(bflo(yw[buf][i])) * hh.x, o1 = gelu_tanh(bfhi(yw[buf][i])) * hh.y; *(unsigned*)(MIXO2 + (size_t)(r0 + (i0_) + i) * DR + c) = cvt_pk_bf16(o0, o1); } } } while (0)
        SCAN_LOAD(0, 0);
        for (int i0 = 0; i0 < nrow; i0 += 16) {
            SCAN_LOAD(1, i0 + 8);
            SCAN_COMPUTE(0, i0);
            if (i0 + 16 < nrow) SCAN_LOAD(0, i0 + 16);
            SCAN_COMPUTE(1, i0 + 8);
        }
#undef SCAN_LOAD
#undef SCAN_COMPUTE
        if (PASS == 1) { *(f32x2*)(AGA + (size_t)tile * DR + c) = aa; *(f32x2*)(AGH + (size_t)tile * DR + c) = hh; }
        else if (sample) *(f32x2*)(out + O_RGS + (size_t)sb * DR + c) = hh;
    }
}
namespace gl {
constexpr int PX = 328, PG = 648;
constexpr int OFF_XC = 0, OFF_G = 64 * PX * 2, OFF_END = OFF_G + 64 * PG * 2;
constexpr int OFF_CST = LDSCTL_OFF + 1024;
static_assert(OFF_CST + 8 * 320 * 4 <= LDS_BYTES, "gate core constants");
static_assert(OFF_END <= RING_BYTES, "gate core LDS");
__device__ __forceinline__ void load_x(u32x4 (&xr)[11], const bf16_t* PROJ2, int tile, int blk, int tid) {
    const bool sample = tile >= 256; const int r0 = sample ? MP + (tile - 256) * 64 : tile * 64; const int L = 64; const bool start = sample || (tile & 127) == 0;
    const int c8 = tid % 40, tg = tid / 40; const int ch = blk * 320 + c8 * 8; const int t0 = tg * 8;
#pragma unroll
    for (int i = 0; i < 11; ++i) { const int t = t0 - 3 + i; xr[i] = (u32x4){0u, 0u, 0u, 0u};
        if (tid < 320 && t < L && (t >= 0 || !start)) xr[i] = __builtin_nontemporal_load((const u32x4*)(PROJ2 + (size_t)(r0 + t) * OIN + ch)); }
}
__device__ __forceinline__ void load_consts(LAS unsigned char* lds, const float* ga_b, const float* gx_b, const float* SP8, const float* cw, const float* cb, int blk, int tid) {
    LAS float* C = (LAS float*)(lds + OFF_CST);
    for (int i = tid; i < 8 * 320; i += 512) { const int a = i / 320, c = i % 320; const int ch = blk * 320 + c;
        C[i] = a < 4 ? cw[a * DR + ch] : a == 4 ? cb[ch] : a == 5 ? SP8[ch] : a == 6 ? ga_b[ch] : gx_b[ch]; }
}
__device__ __forceinline__ void unit(LAS unsigned char* lds, const bf16_t* PROJ2, const bf16_t* GW,
                                     const float* sconv, bf16_t* LAB, float* AGA, float* AGH, float* out, int tile, int blk, u32x4 (&xr)[11], int next_tile) {
    const LAS float* CST = (const LAS float*)(lds + OFF_CST);
    const int tid = tid_l(), wid = __builtin_amdgcn_readfirstlane(tid >> 6), lane = tid & 63, fr = lane & 15, fq = lane >> 4;
    LAS bf16_t* XC = (LAS bf16_t*)(lds + OFF_XC); LAS bf16_t* GT = (LAS bf16_t*)(lds + OFF_G);
    const bool sample = tile >= 256; const int sb2 = 2 * (tile - 256);
    const int r0 = sample ? MP + sb2 * DECS : tile * 64; const int L = 64;
    const bool start = sample || (tile & 127) == 0;
    const bool first = !sample && (tile & 127) == 0;
    const int cbase = blk * 320;
    if (tid < 320) {
        const int c8 = tid % 40, tg = tid / 40; const int ch = cbase + c8 * 8;
        float w[4][8], bias[8];
#pragma unroll
        for (int j = 0; j < 4; ++j) { const f32x4 a = *(const LAS f32x4*)(CST + j * 320 + c8 * 8), b = *(const LAS f32x4*)(CST + j * 320 + c8 * 8 + 4);
            w[j][0] = a.x; w[j][1] = a.y; w[j][2] = a.z; w[j][3] = a.w; w[j][4] = b.x; w[j][5] = b.y; w[j][6] = b.z; w[j][7] = b.w; }
        { const f32x4 a = *(const LAS f32x4*)(CST + 4 * 320 + c8 * 8), b = *(const LAS f32x4*)(CST + 4 * 320 + c8 * 8 + 4); bias[0] = a.x; bias[1] = a.y; bias[2] = a.z; bias[3] = a.w; bias[4] = b.x; bias[5] = b.y; bias[6] = b.z; bias[7] = b.w; }
        const int t0 = tg * 8;
        float h3[8], h2[8], h1[8];
#define GL_UNPACK(dst, v) do { dst[0] = bflo(v.x); dst[1] = bfhi(v.x); dst[2] = bflo(v.y); dst[3] = bfhi(v.y); dst[4] = bflo(v.z); dst[5] = bfhi(v.z); dst[6] = bflo(v.w); dst[7] = bfhi(v.w); } while (0)
        GL_UNPACK(h3, xr[0]); GL_UNPACK(h2, xr[1]); GL_UNPACK(h1, xr[2]);
        if (sample && (tg & 3) == 0) {
            const float* sp = sconv + (size_t)(sb2 + (tg >> 2)) * 3 * DR + ch;
#pragma unroll
            for (int e = 0; e < 8; ++e) { h3[e] = sp[e]; h2[e] = sp[DR + e]; h1[e] = sp[2 * DR + e]; } }
#pragma unroll
        for (int i = 0; i < 8; ++i) { float x[8], cv[8]; GL_UNPACK(x, xr[3 + i]);
#pragma unroll
            for (int e = 0; e < 8; ++e) { cv[e] = (t0 + i < L) ? bias[e] + w[0][e] * h3[e] + w[1][e] * h2[e] + w[2][e] * h1[e] + w[3][e] * x[e] : 0.f; h3[e] = h2[e]; h2[e] = h1[e]; h1[e] = x[e]; }
            u32x4 o; o.x = cvt_pk_bf16(cv[0], cv[1]); o.y = cvt_pk_bf16(cv[2], cv[3]); o.z = cvt_pk_bf16(cv[4], cv[5]); o.w = cvt_pk_bf16(cv[6], cv[7]);
            *(LAS u32x4*)(XC + (t0 + i) * PX + c8 * 8) = o; }
        if ((sample && (tg & 3) == 3) || (!sample && (tile & 127) == 127 && tg == 7)) { float* oc = sample ? out + O_CVS + (size_t)(sb2 + (tg >> 2)) * 3 * DR + ch : out + O_CVP + (size_t)(tile >> 7) * 3 * DR + ch;
            *(f32x4*)oc = (f32x4){h3[0], h3[1], h3[2], h3[3]}; *(f32x4*)(oc + 4) = (f32x4){h3[4], h3[5], h3[6], h3[7]};
            *(f32x4*)(oc + DR) = (f32x4){h2[0], h2[1], h2[2], h2[3]}; *(f32x4*)(oc + DR + 4) = (f32x4){h2[4], h2[5], h2[6], h2[7]};
            *(f32x4*)(oc + 2 * DR) = (f32x4){h1[0], h1[1], h1[2], h1[3]}; *(f32x4*)(oc + 2 * DR + 4) = (f32x4){h1[4], h1[5], h1[6], h1[7]}; }
#undef GL_UNPACK
    }
    __syncthreads();
    {
        const bf16_t* grow[5];
#pragma unroll
        for (int t = 0; t < 5; ++t) grow[t] = GW + (size_t)blk * GWN * GWK + ((size_t)(wid * 5 + t) * 10 * 64 + lane) * 8;
        f32x4 acc[5][4];
#pragma unroll
        for (int t = 0; t < 5; ++t)
#pragma unroll
            for (int tt = 0; tt < 4; ++tt) acc[t][tt] = (f32x4){0.f, 0.f, 0.f, 0.f};
        bf16x8 Aw[4][5];
#pragma unroll
        for (int t = 0; t < 5; ++t) { Aw[0][t] = *(const bf16x8*)(grow[t]); Aw[1][t] = *(const bf16x8*)(grow[t] + 512); Aw[2][t] = *(const bf16x8*)(grow[t] + 1024); Aw[3][t] = *(const bf16x8*)(grow[t] + 1536); }
#pragma unroll
        for (int kk = 0; kk < 10; ++kk) {
            bf16x8 Bx[4];
#pragma unroll
            for (int tt = 0; tt < 4; ++tt) Bx[tt] = *(const LAS bf16x8*)(XC + (tt * 16 + fr) * PX + kk * 32 + 8 * fq);
#pragma unroll
            for (int t = 0; t < 5; ++t)
#pragma unroll
                for (int tt = 0; tt < 4; ++tt) acc[t][tt] = __builtin_amdgcn_mfma_f32_16x16x32_bf16(Aw[kk % 4][t], Bx[tt], acc[t][tt], 0, 0, 0);
            if ((kk & 1) && kk + 3 < 10) {
#pragma unroll
                for (int t = 0; t < 5; ++t) { Aw[(kk + 3) % 4][t] = *(const bf16x8*)(grow[t] + (kk + 3) * 512); Aw[(kk + 4) % 4][t] = *(const bf16x8*)(grow[t] + (kk + 4) * 512); } }
        }
        if (next_tile >= 0) load_x(xr, PROJ2, next_tile, blk, tid);
#pragma unroll
        for (int t = 0; t < 5; ++t) { const int c = wid * 40 + 8 * t + 2 * fq;
            const f32x2 ba2 = *(const LAS f32x2*)(CST + 6 * 320 + c), bx2 = *(const LAS f32x2*)(CST + 7 * 320 + c), sp2 = *(const LAS f32x2*)(CST + 5 * 320 + c);
#pragma unroll
            for (int tt = 0; tt < 4; ++tt) { const int tok = tt * 16 + fr; const f32x4 v = acc[t][tt];
                const float r0 = sigm(v[0] + ba2.x), r1 = sigm(v[1] + ba2.y), i0 = sigm(v[2] + bx2.x), i1 = sigm(v[3] + bx2.y);
                const unsigned xw = *(const LAS unsigned*)(XC + tok * PX + c);
                const float la0 = -sp2.x * r0, la1 = -sp2.y * r1; const float a0 = __builtin_amdgcn_exp2f(la0), a1 = __builtin_amdgcn_exp2f(la1);
                float m0 = __builtin_amdgcn_sqrtf(fmaf(-a0, a0, 1.0f)), m1 = __builtin_amdgcn_sqrtf(fmaf(-a1, a1, 1.0f));
                if (first && tok == 0) { m0 = 1.0f; m1 = 1.0f; }
                *(LAS unsigned*)(GT + tok * PG + c) = cvt_pk_bf16(la0, la1);
                *(LAS unsigned*)(GT + tok * PG + 320 + c) = cvt_pk_bf16(m0 * i0 * bflo(xw), m1 * i1 * bfhi(xw)); } }
    }
    __syncthreads();
    {
        const int tok = tid >> 3, sub = tid & 7;
        if (tok < L) {
#pragma unroll
            for (int i = 0; i < 5; ++i) { const int c8 = sub + 8 * i;
                const u32x4 lw = *(const LAS u32x4*)(GT + tok * PG + c8 * 8), bw = *(const LAS u32x4*)(GT + tok * PG + 320 + c8 * 8);
                bf16_t* gp = LAB + (size_t)(r0 + tok) * OIN + cbase + c8 * 8; __builtin_nontemporal_store(lw, (u32x4*)gp); __builtin_nontemporal_store(bw, (u32x4*)(gp + DR)); } }
    }
    if (!sample && tid < 320) { float h = 0.f, ls = 0.f;
        typedef short s16x4 __attribute__((ext_vector_type(4)));
        const int q = fr >> 2, p = fr & 3; const LAS bf16_t* gp = GT + q * PG + (tid & ~15) + 4 * p;
#pragma unroll 4
        for (int t0 = 0; t0 < 64; t0 += 4) {
            const s16x4 lw = __builtin_amdgcn_ds_read_tr16_b64_v4i16((LAS s16x4*)(gp + t0 * PG)), bw = __builtin_amdgcn_ds_read_tr16_b64_v4i16((LAS s16x4*)(gp + t0 * PG + 320));
#pragma unroll
            for (int e = 0; e < 4; ++e) { const float la = bf1((bf16_t)lw[e]), b = bf1((bf16_t)bw[e]); h = __builtin_amdgcn_exp2f(la) * h + b; ls += la; } }
        AGA[(size_t)tile * DR + cbase + tid] = __builtin_amdgcn_exp2f(ls); AGH[(size_t)tile * DR + cbase + tid] = h; }
}
}
__device__ __forceinline__ void scanB_phase(const bf16_t* PROJ2, const bf16_t* LAB, const float* srg, const float* CAR, bf16_t* MIXO2, float* out, int vcu, int G, int tid) {
    for (int u = vcu; u < 288 * 5; u += G) {
        const int tile = u / 5, cg = u % 5; const int c = cg * 1024 + tid * 2;
        const bool sample = tile >= 256; const int sb = tile - 256;
        const int r0 = sample ? MP + sb * 32 : tile * 64; const int nrow = sample ? 32 : 64;
        f32x2 hh = sample ? *(const f32x2*)(srg + (size_t)sb * DR + c) : *(const f32x2*)(CAR + (size_t)tile * DR + c);
        unsigned lw[2][8], bw[2][8], yw[2][8];
#define SB_LOAD(buf, i0_) do { _Pragma("unroll") for (int i = 0; i < 8; ++i) { const size_t ro = (size_t)(r0 + (i0_) + i) * OIN + c; lw[buf][i] = *(const unsigned*)(LAB + ro); bw[buf][i] = *(const unsigned*)(LAB + ro + DR); yw[buf][i] = *(const unsigned*)(PROJ2 + ro + DR); } } while (0)
#define SB_COMPUTE(buf, i0_) do { _Pragma("unroll") for (int i = 0; i < 8; ++i) { \
            hh.x = __builtin_amdgcn_exp2f(bflo(lw[buf][i])) * hh.x + bflo(bw[buf][i]); hh.y = __builtin_amdgcn_exp2f(bfhi(lw[buf][i])) * hh.y + bfhi(bw[buf][i]); \
            *(unsigned*)(MIXO2 + (size_t)(r0 + (i0_) + i) * DR + c) = cvt_pk_bf16(gelu_tanh(bflo(yw[buf][i])) * hh.x, gelu_tanh(bfhi(yw[buf][i])) * hh.y); } } while (0)
        SB_LOAD(0, 0);
        for (int i0 = 0; i0 < nrow; i0 += 16) {
            SB_LOAD(1, i0 + 8);
            SB_COMPUTE(0, i0);
            if (i0 + 16 < nrow) SB_LOAD(0, i0 + 16);
            SB_COMPUTE(1, i0 + 8);
        }
#undef SB_LOAD
#undef SB_COMPUTE
        if (sample) *(f32x2*)(out + O_RGS + (size_t)sb * DR + c) = hh;
    }
}
__device__ __forceinline__ void carry_phase(const float* AGA, const float* AGH, float* CAR, float* out, int vcu, int tid) {
    const int wave = tid >> 6, lane = tid & 63, ci = lane & 15, seg = lane >> 4;
    const int chain = (vcu * NWAVES + wave) * 16 + ci; if ((vcu * NWAVES + wave) * 16 >= NBATCH * DR) return;
    const int b = chain / DR, c = chain % DR; const size_t base = (size_t)(b * 128 + seg * 32) * DR + c;
    float a[32], hv[32];
#pragma unroll
    for (int j = 0; j < 32; ++j) { a[j] = AGA[base + (size_t)j * DR]; hv[j] = AGH[base + (size_t)j * DR]; }
    float A = 1.f, H = 0.f;
#pragma unroll
    for (int j = 0; j < 32; ++j) { H = a[j] * H + hv[j]; A *= a[j]; }
    const float H0 = __shfl(H, ci), H1 = __shfl(H, ci + 16), H2 = __shfl(H, ci + 32), A1 = __shfl(A, ci + 16), A2 = __shfl(A, ci + 32);
    const float c1 = H0, c2 = A1 * c1 + H1, c3 = A2 * c2 + H2;
    float carry = seg == 0 ? 0.f : seg == 1 ? c1 : seg == 2 ? c2 : c3;
#pragma unroll
    for (int j = 0; j < 32; ++j) { CAR[base + (size_t)j * DR] = carry; carry = a[j] * carry + hv[j]; }
    if (seg == 3) out[O_RGP + (size_t)b * DR + c] = carry;
}

constexpr int NPH = 20;
struct Args { const float* in[25]; float* out; unsigned char* ws; int ph_lo, ph_hi; };
static_assert(sizeof(Args) == 224, "Args has no padding");
typedef __attribute__((address_space(4))) const unsigned char* kargp_t;
__device__ __forceinline__ kargp_t kargs() { kargp_t kp = (kargp_t)__builtin_amdgcn_kernarg_segment_ptr(); asm volatile("" : "+s"(kp)); return kp; }
#define KIN(i) (*(const float* const __attribute__((address_space(4)))*)(kargs() + 8 * (i)))
#define KOUT() (*(float* const __attribute__((address_space(4)))*)(kargs() + 200))
#define KWS() (*(unsigned char* const __attribute__((address_space(4)))*)(kargs() + 208))
__global__ void __launch_bounds__(NWAVES * 64, 2) fwd(Args args_unused) {
    extern __shared__ __attribute__((aligned(16))) unsigned char lds_raw[];
    LAS unsigned char* lds = (LAS unsigned char*)lds_raw;
#define tid (tid_l())
#define lane (tid_l() & 63)
    const int wave = __builtin_amdgcn_readfirstlane(tid >> 6);
    const int G = gridDim.x; const int bx = blockIdx.x; const int vcu = (G % 8 == 0) ? (bx % 8) * (G / 8) + bx / 8 : bx;
    const int gw = vcu * NWAVES + wave, NGW = G * NWAVES;
    for (int u = tid; u < (LDS_BYTES - LDSCTL_OFF) / 4; u += NWAVES * 64) ((LAS unsigned*)(lds + LDSCTL_OFF))[u] = 0u;
    __syncthreads();
    volatile LAS unsigned* MISC = (volatile LAS unsigned*)(lds + MISC_OFF);
    XcdBarrier bar; bar.bar = (unsigned*)(KWS() + WS_CTL) + CW_BAR; bar.x = 0; bar.st = nullptr;
    bar = xcd_barrier_post((unsigned*)(KWS() + WS_CTL) + CW_BAR, MISC + 8);
    const int lo = *(const int __attribute__((address_space(4)))*)(kargs() + 216), hi = *(const int __attribute__((address_space(4)))*)(kargs() + 220);
#define IN(k) (lo <= (k) && (k) < hi)
    unsigned* const bgctl = (unsigned*)(KWS() + WS_CTL);
#define SEAM(k) do { if (IN(k) && IN((k) + 1)) xcd_barrier_bg(bar, bgctl, lds, MISC + 16); } while (0)
#define DRAIN(e) bg_drain(bgctl, (unsigned)(e), lds, MISC + 16)

    if (IN(0)) {
        unsigned char* ws = KWS();
        LAS float* scr = (LAS float*)(lds + wave * 16384);
        constexpr int I_INE = (D / 64) * (EIN / 32);
        for (int it = gw; it < I_INE; it += 2 * NGW) {
            constexpr int nblk = EIN / 32; const int it2 = it + NGW; const bool two = it2 < I_INE;
            BgItem a, b; a.W = KIN(9); a.WT = (bf16_t*)(ws + WS_WINE); a.gain = nullptr; a.ldw = EIN; a.ldo = D; a.perm = 0; a.k0 = 64 * (it / nblk); a.n0 = 32 * (it % nblk);
            b = a; if (two) { b.k0 = 64 * (it2 / nblk); b.n0 = 32 * (it2 % nblk); }
            f32x4 va[8], vb[8];
            bg_load(va, a, lane); if (two) bg_load(vb, b, lane);
            bg_finish<false>(va, a, scr, lane); if (two) bg_finish<false>(vb, b, scr, lane); }
        { const float* lb_logits = KIN(10); float* LB = (float*)(ws + WS_LB);
          for (int i = gw * 64 + lane; i < 2048; i += NGW * 64) { const float a = lb_logits[i], b = lb_logits[2048 + i], c = lb_logits[4096 + i]; const float mx = fmaxf(a, fmaxf(b, c));
            const float ea = fexp(a - mx), eb = fexp(b - mx), ec = fexp(c - mx); LB[i] = ea / (ea + eb + ec); } }
        { const float* lam = KIN(21); float* SP8 = (float*)(ws + WS_SP8);
          for (int i = gw * 64 + lane; i < DR; i += NGW * 64) { const float l = -lam[i]; const float e = fexp(-fabsf(l)); const float l1p = e < 1e-4f ? e * (1.0f - 0.5f * e) : flog(1.0f + e); SP8[i] = 8.0f * 1.4426950408889634f * (fmaxf(l, 0.f) + l1p);     } }
        { f32x2* ROT = (f32x2*)(ws + WS_ROT);
          for (int i = gw * 64 + lane; i < SEQ * 64; i += NGW * 64) { const int pos = i >> 6, fi = i & 63; const float inv = __builtin_amdgcn_exp2f(-(float)fi * (13.287712379549449f / 63.0f));
            const float ang = (float)pos * inv; const float rev = ang * 0.15915494309189535f; const float fr_ = rev - floorf(rev);
            ROT[i] = (f32x2){__builtin_amdgcn_cosf(fr_), __builtin_amdgcn_sinf(fr_)}; } }
        rms_phase<false>(KIN(0), KIN(1), nullptr, nullptr, KIN(6), (bf16_t*)(ws + WS_XN), nullptr, gw, NGW, lane);
    }
    SEAM(0);
    if (IN(1)) { unsigned char* ws = KWS(); pg8::Gemm g{(bf16_t*)(ws + WS_XN), (bf16_t*)(ws + WS_WINE), D, D, D, 0, 0}; pg8::StaticOrder S; S.init(M, EIN, G, bx); pg8::EpiBf16<0> E{(bf16_t*)(ws + WS_PROJ), EIN, nullptr};
        pg8::gemm_phase<pg8::EpiBf16<0>, pg8::StaticOrder, true>(lds, g, S, E); }
    SEAM(1);
    if (IN(2)) {
        unsigned char* ws = KWS();
        { bf16_t* PROJ = (bf16_t*)(ws + WS_PROJ); const float* LB = (const float*)(ws + WS_LB); const f32x2* ROT = (const f32x2*)(ws + WS_ROT); float* DECB = (float*)(ws + WS_AGA);
          const int el = tid >> 3, kc = (tid & 7) * 8; constexpr int NU = mix::NCHUNK * 24;
          mix::Raw rcur, rnxt; int row0, L, pos0, hd, cidx;
          if (vcu < NU) { mix::prep_decode(vcu, row0, L, pos0, hd, cidx); mix::prep_load(rcur, PROJ, ROT, row0, L, pos0, hd, el, kc); }
          for (int u = vcu; u < NU; u += G) {
              int row0n = 0, Ln = 0, pos0n = 0, hdn = 0, cidxn = 0;
              if (u + G < NU) { mix::prep_decode(u + G, row0n, Ln, pos0n, hdn, cidxn); mix::prep_load(rnxt, PROJ, ROT, row0n, Ln, pos0n, hdn, el, kc); }
              mix::prep_unit(lds, rcur, PROJ, LB, DECB, row0, L, hd, cidx, tid);
              rcur = rnxt; row0 = row0n; L = Ln; pos0 = pos0n; hd = hdn; cidx = cidxn;
          } }
        xcd_barrier_bg(bar, bgctl, lds, MISC + 16);
        { float* out = KOUT();
          const bf16_t* PROJ = (const bf16_t*)(ws + WS_PROJ); bf16_t* ORAW = (bf16_t*)(ws + WS_ORAW); const float* DECB = (const float*)(ws + WS_AGA);
          {
            for (int it = vcu; it < 256; it += G) {
                const int kind = it >> 7, r = it & 127, b = r >> 6; int h, vs; if (kind == 0) { h = (r >> 2) & 15; vs = r & 3; } else { h = (r >> 3) & 7; vs = r & 7; }
                if (kind == 0) mix::chain<0, false>(lds, PROJ, ORAW, DECB, b * SEQ, SEQ / 64, b * (SEQ / 64), 0, 0, h, vs, nullptr, out + O_HGP + (size_t)b * 16 * 16384);
                else mix::chain<1, false>(lds, PROJ, ORAW, DECB, b * SEQ, SEQ / 64, b * (SEQ / 64), 0, 0, h, vs, nullptr, out + O_RTP + (size_t)b * 8 * 32768);
                __syncthreads();
            }
            if ((G % 128) == 0 && (32 % (G >> 7)) == 0) {
                const int r = vcu & 127, sb0 = vcu >> 7, sbs = G >> 7, n = 32 / sbs;
                if (r < 64) mix::chain<0, true>(lds, PROJ, ORAW, DECB, 0, n, 0, sb0, sbs, r >> 2, r & 3, KIN(2), out + O_HGS);
                else mix::chain<1, true>(lds, PROJ, ORAW, DECB, 0, n, 0, sb0, sbs, (r - 64) >> 3, r & 7, KIN(3), out + O_RTS);
                __syncthreads();
            } else {
                for (int it = vcu; it < 4096; it += G) { const int sb = it >> 7, r = it & 127;
                    if (r < 64) mix::chain<0, true>(lds, PROJ, ORAW, DECB, 0, 1, 0, sb, 0, r >> 2, r & 3, KIN(2), out + O_HGS);
                    else mix::chain<1, true>(lds, PROJ, ORAW, DECB, 0, 1, 0, sb, 0, (r - 64) >> 3, r & 7, KIN(3), out + O_RTS);
                    __syncthreads(); }
            }
          } }
    }
    SEAM(2);
    if (IN(3)) { unsigned char* ws = KWS(); headnorm_phase((const bf16_t*)(ws + WS_ORAW), (const bf16_t*)(ws + WS_PROJ), KIN(11), KIN(12), (bf16_t*)(ws + WS_MIXO), gw, NGW, lane); }
    DRAIN(BG_E1);
    SEAM(3);
    if (IN(4)) { unsigned char* ws = KWS();
        { pg8::Gemm g{(bf16_t*)(ws + WS_MIXO), (bf16_t*)(ws + WS_WOUTE), D, D, D, 0, 0}; pg8::StaticOrder S; S.init(MP, D, G, bx); pg8::EpiResNorm<true> E{KIN(0), (bf16_t*)(ws + WS_XN), (float*)(ws + WS_CAR)};
          pg8::gemm_phase<pg8::EpiResNorm<true>, pg8::StaticOrder, true>(lds, g, S, E); }
        { pg8::Gemm g{(bf16_t*)(ws + WS_MIXO), (bf16_t*)(ws + WS_WOUTE), D, D, D / 4, (size_t)(D / 4) * 2, (size_t)(D / 4) * 2}; pg8::SplitOrder S{G, bx}; pg8::EpiPart E{(bf16_t*)(ws + WS_PART)};
          pg8::gemm_phase<pg8::EpiPart, pg8::SplitOrder, true>(lds, g, S, E); } }
    SEAM(4);
    if (IN(5)) { unsigned char* ws = KWS(); float* out = KOUT(); mini_norm_phase(KIN(1), (const bf16_t*)(ws + WS_PART), (bf16_t*)(ws + WS_XN), (const float*)(ws + WS_CAR), (float*)(ws + WS_AGH), gw, NGW, lane, vcu, G, tid); }
    DRAIN(BG_E2);
    SEAM(5);
    if (IN(6)) { unsigned char* ws = KWS(); pg8::Gemm g{(bf16_t*)(ws + WS_XN), (bf16_t*)(ws + WS_WUP), D, D, D, 0, 0}; pg8::StaticOrder S; S.init(M, FF, G, bx); pg8::EpiBf16<1> E{(bf16_t*)(ws + WS_HID), FF, (const float*)(ws + WS_AGH)};
        pg8::gemm_phase<pg8::EpiBf16<1>, pg8::StaticOrder, true>(lds, g, S, E); }
    DRAIN(BG_E3);
    SEAM(6);
    if (IN(7)) { unsigned char* ws = KWS(); float* out = KOUT();
        { pg8::Gemm g{(bf16_t*)(ws + WS_HID), (bf16_t*)(ws + WS_WDN), FF, FF, FF, 0, 0}; pg8::StaticOrder S; S.init(MP, D, G, bx); pg8::EpiResNorm<false> E{nullptr, (bf16_t*)(ws + WS_XN), (float*)(ws + WS_CAR)};
          pg8::gemm_phase<pg8::EpiResNorm<false>, pg8::StaticOrder, true>(lds, g, S, E); }
        { pg8::Gemm g{(bf16_t*)(ws + WS_HID), (bf16_t*)(ws + WS_WDN), FF, FF, FF / 4, (size_t)(FF / 4) * 2, (size_t)(FF / 4) * 2}; pg8::SplitOrder S{G, bx}; pg8::EpiPart E{(bf16_t*)(ws + WS_PART)};
          pg8::gemm_phase<pg8::EpiPart, pg8::SplitOrder, true>(lds, g, S, E); } }
    SEAM(7);
    if (IN(8)) { unsigned char* ws = KWS(); float* out = KOUT(); mini_norm_phase(nullptr, (const bf16_t*)(ws + WS_PART), (bf16_t*)(ws + WS_XN), (const float*)(ws + WS_CAR), (float*)(ws + WS_AGH), gw, NGW, lane, vcu, G, tid); }
    DRAIN(BG_E4);
    SEAM(8);
    if (IN(9)) { unsigned char* ws = KWS(); pg8::Gemm g{(bf16_t*)(ws + WS_XN), (bf16_t*)(ws + WS_WINO), D, D, D, 0, 0}; pg8::StaticOrder S; S.init(M, OIN, G, bx); pg8::EpiBf16<0> E{(bf16_t*)(ws + WS_PROJ2), OIN, (const float*)(ws + WS_AGH)};
        pg8::gemm_phase<pg8::EpiBf16<0>, pg8::StaticOrder, true>(lds, g, S, E); }
    DRAIN(BG_E5);
    SEAM(9);
    if (IN(10)) { unsigned char* ws = KWS(); float* out = KOUT();
        const bool xl = (G == 256); const int nu = xl ? 17 : (272 * 16 - vcu + G - 1) / G;
        const int blk0 = xl ? 2 * (vcu >> 5) + (vcu & 1) : (vcu & 15);
        const bool fixed_blk = xl || (G % 16) == 0;
        u32x4 xr[11];
        int tile = xl ? ((vcu & 31) >> 1) : (vcu >> 4), blk = blk0;
        if (nu > 0) { gl::load_consts(lds, KIN(18), KIN(20), (const float*)(ws + WS_SP8), KIN(15), KIN(16), blk, tid); gl::load_x(xr, (const bf16_t*)(ws + WS_PROJ2), tile, blk, tid); __syncthreads(); }
        for (int i = 0; i < nu; ++i) {
            int ntile = -1, nblk = blk;
            if (i + 1 < nu) { if (xl) ntile = tile + 16; else { const int u2 = vcu + G * (i + 1); ntile = u2 >> 4; nblk = u2 & 15; } }
            gl::unit(lds, (const bf16_t*)(ws + WS_PROJ2), (const bf16_t*)(ws + WS_GW), KIN(5), (bf16_t*)(ws + WS_GATES), (float*)(ws + WS_AGA), (float*)(ws + WS_AGH), out, tile, blk, xr, fixed_blk ? ntile : -1);
            if (!fixed_blk && ntile >= 0) { __syncthreads(); gl::load_consts(lds, KIN(18), KIN(20), (const float*)(ws + WS_SP8), KIN(15), KIN(16), nblk, tid); gl::load_x(xr, (const bf16_t*)(ws + WS_PROJ2), ntile, nblk, tid); __syncthreads(); }
            tile = ntile; blk = nblk; }
        __syncthreads(); }
    SEAM(10);
    if (IN(13)) { unsigned char* ws = KWS(); carry_phase((const float*)(ws + WS_AGA), (const float*)(ws + WS_AGH), (float*)(ws + WS_CAR), KOUT(), vcu, tid); }
    SEAM(13);
    if (IN(14)) { unsigned char* ws = KWS(); scanB_phase((const bf16_t*)(ws + WS_PROJ2), (const bf16_t*)(ws + WS_GATES), KIN(4), (const float*)(ws + WS_CAR), (bf16_t*)(ws + WS_XC), KOUT(), vcu, G, tid); }
    DRAIN(BG_E6);
    SEAM(14);
    if (IN(15)) { unsigned char* ws = KWS(); float* out = KOUT();
        { pg8::Gemm g{(bf16_t*)(ws + WS_XC), (bf16_t*)(ws + WS_WOUTO), DR, DR, DR, 0, 0}; pg8::StaticOrder S; S.init(MP, D, G, bx); pg8::EpiResNorm<false> E{nullptr, (bf16_t*)(ws + WS_XN), (float*)(ws + WS_CAR)};
          pg8::gemm_phase<pg8::EpiResNorm<false>, pg8::StaticOrder, true>(lds, g, S, E); }
        { pg8::Gemm g{(bf16_t*)(ws + WS_XC), (bf16_t*)(ws + WS_WOUTO), DR, DR, DR / 4, (size_t)(DR / 4) * 2, (size_t)(DR / 4) * 2}; pg8::SplitOrder S{G, bx}; pg8::EpiPart E{(bf16_t*)(ws + WS_PART)};
          pg8::gemm_phase<pg8::EpiPart, pg8::SplitOrder, true>(lds, g, S, E); } }
    SEAM(15);
    if (IN(16)) { unsigned char* ws = KWS(); float* out = KOUT(); mini_norm_phase(nullptr, (const bf16_t*)(ws + WS_PART), (bf16_t*)(ws + WS_XN), (const float*)(ws + WS_CAR), (float*)(ws + WS_AGH), gw, NGW, lane, vcu, G, tid); }
    DRAIN(BG_E7);
    SEAM(16);
    if (IN(17)) { unsigned char* ws = KWS(); pg8::Gemm g{(bf16_t*)(ws + WS_XN), (bf16_t*)(ws + WS_WUP) + (size_t)D * FF, D, D, D, 0, 0}; pg8::StaticOrder S; S.init(M, FF, G, bx); pg8::EpiBf16<1> E{(bf16_t*)(ws + WS_HID), FF, (const float*)(ws + WS_AGH)};
        pg8::gemm_phase<pg8::EpiBf16<1>, pg8::StaticOrder, true>(lds, g, S, E); }
    DRAIN(BG_E8);
    SEAM(17);
    if (IN(18)) { unsigned char* ws = KWS(); float* out = KOUT();
        { pg8::Gemm g{(bf16_t*)(ws + WS_HID), (bf16_t*)(ws + WS_WDN) + (size_t)D * FF, FF, FF, FF, 0, 0}; pg8::StaticOrder S; S.init(MP, D, G, bx); pg8::EpiResNorm<false> E{nullptr, (bf16_t*)(ws + WS_XN), (float*)(ws + WS_CAR)};
          pg8::gemm_phase<pg8::EpiResNorm<false>, pg8::StaticOrder, true>(lds, g, S, E); }
        { pg8::Gemm g{(bf16_t*)(ws + WS_HID), (bf16_t*)(ws + WS_WDN) + (size_t)D * FF, FF, FF, FF / 4, (size_t)(FF / 4) * 2, (size_t)(FF / 4) * 2}; pg8::SplitOrder S{G, bx}; pg8::EpiPart E{(bf16_t*)(ws + WS_PART)};
          pg8::gemm_phase<pg8::EpiPart, pg8::SplitOrder, true>(lds, g, S, E); } }
    SEAM(18);
    if (IN(19)) { unsigned char* ws = KWS(); final_norm_phase((const bf16_t*)(ws + WS_XN), (const bf16_t*)(ws + WS_PART), KIN(8), KOUT(), gw, NGW, lane); }
#undef IN
#undef SEAM
#undef DRAIN
#undef tid
#undef lane
}

extern "C" void kernel_launch(void* const* d_in, const int* in_sizes, int n_in, void* d_out, int out_size, void* d_ws, size_t ws_size, hipStream_t stream) {
    static int grid = 0;
    if (grid == 0) {
        if (n_in != 25 || (size_t)out_size != O_END || ws_size < WS_END) { fprintf(stderr, "kernel_launch: unexpected shapes (n_in %d, out %d, ws %zu); nothing launched\n", n_in, out_size, ws_size); grid = -1; return; }
        int dev = 0, cus = 0, per_cu = 0;
        if (hipGetDevice(&dev) != hipSuccess || hipDeviceGetAttribute(&cus, hipDeviceAttributeMultiprocessorCount, dev) != hipSuccess) { grid = -1; return; }
        if (hipFuncSetAttribute((const void*)fwd, hipFuncAttributeMaxDynamicSharedMemorySize, LDS_BYTES) != hipSuccess) { fprintf(stderr, "kernel_launch: hipFuncSetAttribute failed\n"); grid = -1; return; }
        if (hipOccupancyMaxActiveBlocksPerMultiprocessor(&per_cu, (const void*)fwd, NWAVES * 64, LDS_BYTES) != hipSuccess || per_cu < 1) { fprintf(stderr, "kernel_launch: occupancy query says %d\n", per_cu); }
        (void)hipGetLastError();
        grid = cus;
    }
    if (grid < 0) return;
    if (hipMemsetAsync((char*)d_ws + WS_CTL, 0, CTL_ZERO_BYTES, stream) != hipSuccess) return;
    Args a{};
    for (int i = 0; i < 25; ++i) a.in[i] = (const float*)d_in[i];
    a.out = (float*)d_out; a.ws = (unsigned char*)d_ws;
    a.ph_lo = 0; a.ph_hi = NPH;
    hipLaunchKernelGGL(fwd, dim3(grid), dim3(NWAVES * 64), LDS_BYTES, stream, a);
}
```

```cpp
#include <hip/hip_runtime.h>
#include <cstdio>
#include <cstdint>

#define GAS __attribute__((address_space(1)))
#define LAS __attribute__((address_space(3)))
typedef unsigned short bf16_t;
typedef short bf16x8 __attribute__((ext_vector_type(8)));
typedef float f32x4 __attribute__((ext_vector_type(4)));
typedef float f32x2 __attribute__((ext_vector_type(2)));
typedef unsigned u32x4 __attribute__((ext_vector_type(4)));
typedef unsigned u32x2 __attribute__((ext_vector_type(2)));


constexpr int D = 4096, SEQ = 8192, NBATCH = 2, DECB = 32, DECS = 32, PAST = 4096;
constexpr int MP = NBATCH * SEQ;
constexpr int MS = DECB * DECS;
constexpr int M = MP + MS;
constexpr int EIN = 14336, FF = 16384, DR = 5120, OIN = 10240;
constexpr float EPS = 1e-6f;
constexpr size_t O_Y = 0;
constexpr size_t O_HGP = (size_t)M * D;
constexpr size_t O_RTP = O_HGP + 524288;
constexpr size_t O_RGP = O_RTP + 524288;
constexpr size_t O_CVP = O_RGP + 10240;
constexpr size_t O_HGS = O_CVP + 30720;
constexpr size_t O_RTS = O_HGS + 8388608;
constexpr size_t O_RGS = O_RTS + 8388608;
constexpr size_t O_CVS = O_RGS + 163840;
constexpr size_t O_END = O_CVS + 491520;

constexpr size_t MiB = 1u << 20;
constexpr size_t WS_CTL = 0, CTL_ZERO_BYTES = 32 * 1024;
constexpr size_t WS_LB = 1 * MiB, WS_SP8 = 1 * MiB + 16384;
constexpr size_t WS_ROT = 2 * MiB;
constexpr size_t WS_AGA = 6 * MiB, WS_AGH = 11 * MiB, WS_CAR = 16 * MiB;
constexpr size_t WS_WINE = 24 * MiB, WS_WOUTE = 136 * MiB, WS_WUP = 168 * MiB, WS_WDN = 424 * MiB, WS_WINO = 680 * MiB, WS_WOUTO = 760 * MiB, WS_GW = 800 * MiB;
constexpr size_t WS_XN = 810 * MiB;
constexpr size_t WS_BIG = 946 * MiB;
constexpr size_t WS_PROJ = WS_BIG, WS_ORAW = WS_BIG + 476 * MiB  , WS_MIXO = WS_BIG + 748 * MiB;
constexpr size_t WS_HID = WS_BIG;
constexpr size_t WS_PROJ2 = WS_BIG, WS_XC = WS_BIG + 340 * MiB, WS_GATES = WS_BIG + 514 * MiB;
constexpr size_t WS_PART = WS_BIG + 884 * MiB;
constexpr size_t WS_END = WS_PART + 64 * MiB;
constexpr int CW_TMO = 0, CW_BAR = 4096;
constexpr int GWK = 384, GWN = 768;

constexpr int RING_BYTES = 131072;
constexpr int LDSCTL_OFF = RING_BYTES, MISC_OFF = LDSCTL_OFF + 320;
constexpr int LDS_BYTES = 147456;
constexpr int NWAVES = 8;

__device__ __forceinline__ float fexp(float x) { return __builtin_amdgcn_exp2f(x * 1.4426950408889634f); }
__device__ __forceinline__ float flog(float x) { return __builtin_amdgcn_logf(x) * 0.6931471805599453f; }
__device__ __forceinline__ float frcp(float x) { return __builtin_amdgcn_rcpf(x); }
__device__ __forceinline__ float sigm(float x) { return frcp(1.0f + fexp(-x)); }
typedef __bf16 bf16x2_t __attribute__((ext_vector_type(2)));
__device__ __forceinline__ unsigned cvt_pk_bf16(float lo, float hi) { const f32x2 v = {lo, hi}; const bf16x2_t r = __builtin_convertvector(v, bf16x2_t); return __builtin_bit_cast(unsigned, r); }
__device__ __forceinline__ float bflo(unsigned w) { return __uint_as_float(w << 16); }
__device__ __forceinline__ float bfhi(unsigned w) { return __uint_as_float(w & 0xffff0000u); }
__device__ __forceinline__ float bf1(bf16_t b) { return __uint_as_float(((unsigned)b) << 16); }
template <int CTRL> __device__ __forceinline__ float dpp_f(float v) { return __builtin_bit_cast(float, __builtin_amdgcn_update_dpp(0, __builtin_bit_cast(int, v), CTRL, 0xf, 0xf, true)); }
__device__ __forceinline__ float row16_sum(float v) { v += dpp_f<0xB1>(v); v += dpp_f<0x4E>(v); v += dpp_f<0x141>(v); v += dpp_f<0x140>(v); return v; }
__device__ __forceinline__ float wave_sum(float v) { v = row16_sum(v); v += __shfl_xor(v, 16); v += __shfl_xor(v, 32); return v; }
__device__ __forceinline__ int tid_l() { int t = (int)__builtin_amdgcn_workitem_id_x(); asm volatile("" : "+v"(t)); return t; }
#define LDS_WAIT() asm volatile("s_waitcnt lgkmcnt(0)" ::: "memory")
#define VM_WAIT() asm volatile("s_waitcnt vmcnt(0)" ::: "memory")

namespace pg8 {
constexpr int BM = 256, BK = 64, HALF = 128, HTB = HALF * BK * 2, STAGE_BYTES = 8 * HTB, NXCD = 8, WGM = 4;
__host__ __device__ __forceinline__ int lds_byte(int r, int c) { const int st = (r >> 4) * 2 + (c >> 5), rr = r & 15, cc = c & 31, ob = rr * 64 + cc * 2; return st * 1024 + (ob ^ (((ob >> 9) & 1) << 5)); }
__host__ __device__ __forceinline__ void stage_rc(int b, int& R, int& C) { const int st = b / 1024, sb = b % 1024, swz = sb ^ (((sb >> 9) & 1) << 5); R = (st >> 1) * 16 + swz / 64; C = (st & 1) * 32 + (swz % 64) / 2; }
__host__ __device__ __forceinline__ int perm32(int rho) { const int n = rho >> 4, i = rho & 15; return 8 * (i >> 2) + 4 * n + (i & 3); }

struct Unit { int pm, pn, g; };
struct Gemm { const bf16_t* A; const bf16_t* Bt; int lda, ldb, K; size_t ga, gb; };

struct StaticOrder {
    int nM, nN, nwg, G, c;
    __device__ void init(int M_, int N_, int G_, int c_) { nM = M_ / BM; nN = N_ / BM; nwg = nM * nN; G = G_; c = c_; }
    __device__ bool next(int i, Unit& u) const {
        const long L = (long)i * G + c; if (L >= nwg) return false;
        int wgid = (int)L; { const int q = nwg / NXCD, r = nwg % NXCD, xcd = wgid % NXCD, off = wgid / NXCD; wgid = (xcd < r ? xcd * (q + 1) : r * (q + 1) + (xcd - r) * q) + off; }
        const int nig = WGM * nN, gid = wgid / nig, fm = gid * WGM, gsz = (nM - fm) < WGM ? (nM - fm) : WGM;
        u.pm = fm + ((wgid % nig) % gsz); u.pn = (wgid % nig) / gsz; u.g = 0; return true;
    }
};
struct GroupOrder {
    int G, c;
    __device__ bool next(int i, Unit& u) const {
        const int L = i * G + c; if (L >= 68 * 48) return false;
        u.pm = L / 48; const int rem = L % 48; u.g = rem / 3; u.pn = rem % 3; return true;
    }
};

struct SplitOrder {
    int G, c;
    __device__ bool next(int i, Unit& u) const {
        const int L = i * G + c; if (L >= 256) return false;
        u.g = L & 3; u.pn = (L >> 2) & 15; u.pm = MP / BM + (L >> 6); return true;
    }
};
template <int ACT  > struct EpiBf16 {
    static constexpr bool PERM = true;
    bf16_t* O; int ldc; const float* rs;
    __device__ __forceinline__ void operator()(const f32x4 (&acc)[2][2][4][2], const Unit& u, int wr, int wc, int fr, int fq) const {
        const int row0 = u.pm * BM + wr * 64 + fr; const int col0 = u.pn * BM + wc * 32 + 8 * fq;
        float sc[2][4];
#pragma unroll
        for (int ai = 0; ai < 2; ++ai)
#pragma unroll
            for (int m = 0; m < 4; ++m) sc[ai][m] = rs ? rs[row0 + ai * HALF + m * 16] : 1.0f;
#pragma unroll
        for (int ai = 0; ai < 2; ++ai)
#pragma unroll
            for (int m = 0; m < 4; ++m) { bf16_t* rowp = O + (size_t)(row0 + ai * HALF + m * 16) * ldc + col0;
#pragma unroll
                for (int bj = 0; bj < 2; ++bj) { f32x4 v0 = acc[ai][bj][m][0] * sc[ai][m], v1 = acc[ai][bj][m][1] * sc[ai][m];
                    if (ACT == 1) {
#pragma unroll
                        for (int j = 0; j < 4; ++j) { const float a = fmaxf(v0[j], 0.f), b = fmaxf(v1[j], 0.f); v0[j] = a * a; v1[j] = b * b; } }
                    u32x4 w; w.x = cvt_pk_bf16(v0[0], v0[1]); w.y = cvt_pk_bf16(v0[2], v0[3]); w.z = cvt_pk_bf16(v1[0], v1[1]); w.w = cvt_pk_bf16(v1[2], v1[3]);
                    __builtin_nontemporal_store(w, (u32x4*)(rowp + bj * HALF)); } }
    }
};
struct EpiGates {
    static constexpr bool PERM = true;
    bf16_t* O; const float* ba; const float* bx;
    __device__ __forceinline__ void operator()(const f32x4 (&acc)[2][2][4][2], const Unit& u, int wr, int wc, int fr, int fq) const {
        const int row0 = u.pm * BM + wr * 64 + fr;
#pragma unroll
        for (int bj = 0; bj < 2; ++bj) {
            const int cl = u.pn * BM + bj * HALF + wc * 32 + 8 * fq;
            if (cl < 640) {
                const int gate = cl >= 320 ? 1 : 0; const int ch = u.g * 320 + cl - gate * 320;
                const float* bp = (gate ? bx : ba) + ch; const f32x4 b0 = *(const f32x4*)bp, b1 = *(const f32x4*)(bp + 4);
                bf16_t* colp = O + gate * DR + ch;
#pragma unroll
                for (int ai = 0; ai < 2; ++ai)
#pragma unroll
                    for (int m = 0; m < 4; ++m) { f32x4 v0 = acc[ai][bj][m][0] + b0, v1 = acc[ai][bj][m][1] + b1;
#pragma unroll
                        for (int j = 0; j < 4; ++j) { v0[j] = sigm(v0[j]); v1[j] = sigm(v1[j]); }
                        u32x4 w; w.x = cvt_pk_bf16(v0[0], v0[1]); w.y = cvt_pk_bf16(v0[2], v0[3]); w.z = cvt_pk_bf16(v1[0], v1[1]); w.w = cvt_pk_bf16(v1[2], v1[3]);
                        __builtin_nontemporal_store(w, (u32x4*)(colp + (size_t)(row0 + ai * HALF + m * 16) * OIN)); }
            }
        }
    }
};
struct EpiResF32 {
    static constexpr bool PERM = false;
    const float* baseP; const float* baseS; float* out;
    __device__ __forceinline__ void operator()(const f32x4 (&acc)[2][2][4][2], const Unit& u, int wr, int wc, int fr, int fq) const {
        const int row0 = u.pm * BM + wr * 64 + fr, col0 = u.pn * BM + wc * 32 + 4 * fq;
        const float* bb = (u.pm < MP / BM) ? baseP + (size_t)row0 * D : baseS + (size_t)(row0 - MP) * D;
        float* ob = out + (size_t)row0 * D + col0; bb += col0;
#pragma unroll
        for (int ai = 0; ai < 2; ++ai) {
            f32x4 bs[4][2][2];
#pragma unroll
            for (int m = 0; m < 4; ++m)
#pragma unroll
                for (int bj = 0; bj < 2; ++bj)
#pragma unroll
                    for (int n = 0; n < 2; ++n) bs[m][bj][n] = *(const f32x4*)(bb + (size_t)(ai * HALF + m * 16) * D + bj * HALF + n * 16);
            asm volatile("" ::: "memory");
#pragma unroll
            for (int m = 0; m < 4; ++m)
#pragma unroll
                for (int bj = 0; bj < 2; ++bj)
#pragma unroll
                    for (int n = 0; n < 2; ++n) __builtin_nontemporal_store(bs[m][bj][n] + acc[ai][bj][m][n], (f32x4*)(ob + (size_t)(ai * HALF + m * 16) * D + bj * HALF + n * 16));
            asm volatile("" ::: "memory"); }
    }
};
template <bool XBASE> struct EpiResNorm {
    static constexpr bool PERM = true;
    const float* xbase; bf16_t* HB; float* SSP;
    __device__ __forceinline__ void operator()(const f32x4 (&acc)[2][2][4][2], const Unit& u, int wr, int wc, int fr, int fq) const {
        const int row0 = u.pm * BM + wr * 64 + fr, col0 = u.pn * BM + wc * 32 + 8 * fq;
        const float* xb = xbase + (size_t)row0 * D + col0; bf16_t* hb = HB + (size_t)row0 * D + col0;
#pragma unroll
        for (int ai = 0; ai < 2; ++ai) {
            f32x4 b0[4][2], b1[4][2];
#pragma unroll
            for (int m = 0; m < 4; ++m)
#pragma unroll
                for (int bj = 0; bj < 2; ++bj) { const size_t ro = (size_t)(ai * HALF + m * 16) * D + bj * HALF;
                    if (XBASE) { b0[m][bj] = *(const f32x4*)(xb + ro); b1[m][bj] = *(const f32x4*)(xb + ro + 4); }
                    else { const u32x4 w = *(const u32x4*)(hb + ro); b0[m][bj] = (f32x4){bflo(w.x), bfhi(w.x), bflo(w.y), bfhi(w.y)}; b1[m][bj] = (f32x4){bflo(w.z), bfhi(w.z), bflo(w.w), bfhi(w.w)}; } }
            asm volatile("" ::: "memory");
#pragma unroll
            for (int m = 0; m < 4; ++m) { float ss = 0.f; const size_t ro = (size_t)(ai * HALF + m * 16) * D;
#pragma unroll
                for (int bj = 0; bj < 2; ++bj) { const f32x4 h0 = b0[m][bj] + acc[ai][bj][m][0], h1 = b1[m][bj] + acc[ai][bj][m][1];
                    u32x4 w; w.x = cvt_pk_bf16(h0[0], h0[1]); w.y = cvt_pk_bf16(h0[2], h0[3]); w.z = cvt_pk_bf16(h1[0], h1[1]); w.w = cvt_pk_bf16(h1[2], h1[3]); *(u32x4*)(hb + ro + bj * HALF) = w;
                    const float r0 = bflo(w.x), r1 = bfhi(w.x), r2 = bflo(w.y), r3 = bfhi(w.y), r4 = bflo(w.z), r5 = bfhi(w.z), r6 = bflo(w.w), r7 = bfhi(w.w);
                    ss += ((r0 * r0 + r1 * r1) + (r2 * r2 + r3 * r3)) + ((r4 * r4 + r5 * r5) + (r6 * r6 + r7 * r7)); }
                ss += __shfl_xor(ss, 16); ss += __shfl_xor(ss, 32);
                if (fq == 0) SSP[(size_t)(row0 + ai * HALF + m * 16) * 64 + u.pn * 4 + wc] = ss; }
            asm volatile("" ::: "memory"); }
    }
};
struct EpiPart {
    static constexpr bool PERM = true;
    bf16_t* P;
    __device__ __forceinline__ void operator()(const f32x4 (&acc)[2][2][4][2], const Unit& u, int wr, int wc, int fr, int fq) const {
        const int row0 = (u.pm - MP / BM) * BM + wr * 64 + fr, col0 = u.pn * BM + wc * 32 + 8 * fq;
        bf16_t* ob = P + ((size_t)u.g * MS + row0) * D + col0;
#pragma unroll
        for (int ai = 0; ai < 2; ++ai)
#pragma unroll
            for (int m = 0; m < 4; ++m) { const size_t ro = (size_t)(ai * HALF + m * 16) * D;
#pragma unroll
                for (int bj = 0; bj < 2; ++bj) { const f32x4 v0 = acc[ai][bj][m][0], v1 = acc[ai][bj][m][1];
                    u32x4 w; w.x = cvt_pk_bf16(v0[0], v0[1]); w.y = cvt_pk_bf16(v0[2], v0[3]); w.z = cvt_pk_bf16(v1[0], v1[1]); w.w = cvt_pk_bf16(v1[2], v1[3]);
                    *(u32x4*)(ob + ro + bj * HALF) = w; } }
    }
};

template <class Epi, class Sched, bool ALIGN_EPI>
__device__ __forceinline__ void gemm_phase(LAS unsigned char* lds, const Gemm g, const Sched& S, const Epi& E) {
    const int tid = tid_l(), wid = __builtin_amdgcn_readfirstlane(tid >> 6), lane = tid & 63, wr = wid >> 2, wc = wid & 3, fr = lane & 15, fq = lane >> 4;
    const int K = g.K, nt = K / BK;
    unsigned voffA[2], voffB[2];
#pragma unroll
    for (int i = 0; i < 2; ++i) { int R, C; stage_rc(tid * 16 + i * 8192, R, C); const int Rb = Epi::PERM ? ((R & ~31) + perm32(R & 31)) : R;
        voffA[i] = (unsigned)(R * g.lda + C) * 2u; voffB[i] = (unsigned)(Rb * g.ldb + C) * 2u; }
    const size_t kstep = (size_t)(BK * 2);
    const size_t hA = (size_t)HALF * g.lda * 2, hB = (size_t)HALF * g.ldb * 2;
    const unsigned ldsw = (unsigned)wid * 1024u;
    const int aoff = lds_byte(wr * 64 + fr, fq * 8), boff = lds_byte(wc * 32 + fr, fq * 8);
#define PG8_SA(b, h) (((b) * 2 + (h)) * HTB)
#define PG8_SB(b, h) ((4 + (b) * 2 + (h)) * HTB)
#define PG8_STAGE(bufoff, gbase, voff) do { _Pragma("unroll") for (int _i = 0; _i < 2; ++_i) \
        __builtin_amdgcn_global_load_lds((const unsigned*)((const char*)(gbase) + (voff)[_i]), (LAS unsigned*)(lds + (bufoff) + ldsw + _i * 8192), 16, 0, 0); } while (0)
#define PG8_LDA(dst, b, h) do { _Pragma("unroll") for (int m = 0; m < 4; ++m) _Pragma("unroll") for (int k = 0; k < 2; ++k) dst[m][k] = *(const LAS bf16x8*)(lds + PG8_SA(b, h) + aoff + m * 2048 + k * 1024); } while (0)
#define PG8_LDB(dst, b, h) do { _Pragma("unroll") for (int n = 0; n < 2; ++n) _Pragma("unroll") for (int k = 0; k < 2; ++k) dst[n][k] = *(const LAS bf16x8*)(lds + PG8_SB(b, h) + boff + n * 2048 + k * 1024); } while (0)
#define PG8_MMA(ai, bj, At, Bt) do { __builtin_amdgcn_s_setprio(1); _Pragma("unroll") for (int m = 0; m < 4; ++m) _Pragma("unroll") for (int n = 0; n < 2; ++n) _Pragma("unroll") for (int k = 0; k < 2; ++k) \
        acc[ai][bj][m][n] = __builtin_amdgcn_mfma_f32_16x16x32_bf16(Bt[n][k], At[m][k], acc[ai][bj][m][n], 0, 0, 0); __builtin_amdgcn_s_setprio(0); } while (0)
#define PG8_WAIT_V(n) asm volatile("s_waitcnt vmcnt(" #n ")" ::: "memory")
#define PG8_WAIT_L(n) asm volatile("s_waitcnt lgkmcnt(" #n ")" ::: "memory")
#define PG8_BAR __builtin_amdgcn_s_barrier()
#define PG8_SCHED __builtin_amdgcn_sched_barrier(0)
    Unit cur, nxt; int ui = 0;
    if (!S.next(0, cur)) return;
    f32x4 acc[2][2][4][2];
#pragma unroll
    for (int a = 0; a < 2; ++a)
#pragma unroll
        for (int b = 0; b < 2; ++b)
#pragma unroll
            for (int m = 0; m < 4; ++m)
#pragma unroll
                for (int n = 0; n < 2; ++n) acc[a][b][m][n] = (f32x4){0.f, 0.f, 0.f, 0.f};
    bf16x8 At[4][2], B0[2][2], B1[2][2];
    const char* cA = (const char*)g.A + (size_t)cur.pm * 2 * hA + (size_t)cur.g * g.ga; const char* cB = (const char*)g.Bt + (size_t)cur.pn * 2 * hB + (size_t)cur.g * g.gb;
    PG8_STAGE(PG8_SB(0, 0), cB, voffB); PG8_STAGE(PG8_SB(0, 1), cB + hB, voffB); PG8_STAGE(PG8_SA(0, 0), cA, voffA); PG8_STAGE(PG8_SA(0, 1), cA + hA, voffA);
    if (wr == 1) PG8_BAR;
    PG8_WAIT_V(2); PG8_BAR;
    PG8_STAGE(PG8_SB(1, 0), cB + kstep, voffB); PG8_STAGE(PG8_SA(1, 0), cA + kstep, voffA); PG8_STAGE(PG8_SB(1, 1), cB + hB + kstep, voffB);
    PG8_WAIT_V(6); PG8_BAR;
    for (;;) {
        const bool has_next = S.next(ui + 1, nxt);
        const char* nA = has_next ? (const char*)g.A + (size_t)nxt.pm * 2 * hA + (size_t)nxt.g * g.ga : cA; const char* nB = has_next ? (const char*)g.Bt + (size_t)nxt.pn * 2 * hB + (size_t)nxt.g * g.gb : cB;
#pragma nounroll
        for (int t = 0; t < nt; t += 2) {
            const bool last = (t == nt - 2);
            const char* a1 = cA + (size_t)(t + 1) * kstep;
            const char* a2 = last ? nA : cA + (size_t)(t + 2) * kstep; const char* b2 = last ? nB : cB + (size_t)(t + 2) * kstep;
            const char* a3 = a2 + kstep; const char* b3 = b2 + kstep;
            PG8_LDB(B0, 0, 0); PG8_LDB(B1, 0, 1); PG8_SCHED; PG8_LDA(At, 0, 0); PG8_STAGE(PG8_SA(1, 1), a1 + hA, voffA);
            PG8_WAIT_V(8); PG8_WAIT_L(0); PG8_BAR; PG8_MMA(0, 0, At, B0); PG8_MMA(0, 1, At, B1); PG8_BAR; PG8_SCHED;
            PG8_LDA(At, 0, 1); PG8_STAGE(PG8_SB(0, 0), b2, voffB); PG8_STAGE(PG8_SB(0, 1), b2 + hB, voffB); PG8_STAGE(PG8_SA(0, 0), a2, voffA);
            PG8_WAIT_V(8); PG8_WAIT_L(0); PG8_BAR; PG8_MMA(1, 0, At, B0); PG8_MMA(1, 1, At, B1); PG8_BAR; PG8_SCHED;
            PG8_LDB(B0, 1, 0); PG8_LDB(B1, 1, 1); PG8_SCHED; PG8_LDA(At, 1, 0); PG8_STAGE(PG8_SA(0, 1), a2 + hA, voffA);
            PG8_WAIT_V(8); PG8_WAIT_L(0); PG8_BAR; PG8_MMA(0, 0, At, B0); PG8_MMA(0, 1, At, B1); PG8_BAR; PG8_SCHED;
            PG8_LDA(At, 1, 1); PG8_STAGE(PG8_SB(1, 0), b3, voffB); PG8_STAGE(PG8_SB(1, 1), b3 + hB, voffB); PG8_STAGE(PG8_SA(1, 0), a3, voffA);
            PG8_WAIT_V(8); PG8_WAIT_L(0); PG8_BAR; PG8_MMA(1, 0, At, B0); PG8_MMA(1, 1, At, B1); PG8_BAR; PG8_SCHED;
        }
        if constexpr (ALIGN_EPI) { if (wr == 0) PG8_BAR; }
        E(acc, cur, wr, wc, fr, fq);
        if (!has_next) break;
#pragma unroll
        for (int a = 0; a < 2; ++a)
#pragma unroll
            for (int b = 0; b < 2; ++b)
#pragma unroll
                for (int m = 0; m < 4; ++m)
#pragma unroll
                    for (int n = 0; n < 2; ++n) acc[a][b][m][n] = (f32x4){0.f, 0.f, 0.f, 0.f};
        cur = nxt; cA = nA; cB = nB; ++ui;
        if constexpr (ALIGN_EPI) { if (wr == 1) PG8_BAR; }
    }
    PG8_WAIT_V(0);
    if constexpr (!ALIGN_EPI) { if (wr == 0) PG8_BAR; }
    PG8_BAR;
#undef PG8_SA
#undef PG8_SB
#undef PG8_STAGE
#undef PG8_LDA
#undef PG8_LDB
#undef PG8_MMA
#undef PG8_WAIT_V
#undef PG8_WAIT_L
#undef PG8_BAR
#undef PG8_SCHED
}
}

#define XB_TMO      128
#define XB_XCNT(j)  (256  + 64 * (j))
#define XB_XSUB(j)  (1280 + 64 * (j))
#define XB_XGEN(j)  (2304 + 64 * (j))
#define XB_TOP      3328
#define XB_TOPGEN   3392
#define XCD_BAR_WORDS 3456
#define XB_SPIN_CAP (1u << 18)
__device__ __forceinline__ unsigned xb_ld(unsigned* p)              { return __hip_atomic_load(p, __ATOMIC_RELAXED, __HIP_MEMORY_SCOPE_AGENT); }
__device__ __forceinline__ unsigned xb_add(unsigned* p, unsigned v) { return __hip_atomic_fetch_add(p, v, __ATOMIC_RELAXED, __HIP_MEMORY_SCOPE_AGENT); }
__device__ __forceinline__ unsigned xb_xcc_id() { return (unsigned)__builtin_amdgcn_s_getreg((3 << 11) | 20) & 0xFu; }
#define XB_SPIN(cond, bar) do { unsigned _sp = 0; while (cond) { __builtin_amdgcn_s_sleep(1); \
    if ((++_sp & 255u) == 0u) { if (xb_ld(&(bar)[XB_TMO])) break; if (_sp > XB_SPIN_CAP) { atomicAdd(&(bar)[XB_TMO], 1u); break; } } } } while (0)
struct XcdBarrier { unsigned* bar; unsigned x; volatile LAS unsigned* st; };
__device__ __forceinline__ XcdBarrier xcd_barrier_post(unsigned* bar, volatile LAS unsigned* st) {
    XcdBarrier b; b.bar = bar; b.x = xb_xcc_id(); b.st = st;
    if (threadIdx.x == 0) (void)xb_add(&bar[XB_XCNT(b.x)], 1u);
    return b;
}
__device__ __forceinline__ void xcd_barrier_complete(unsigned* bar, unsigned x, unsigned& nloc, unsigned& nx) {
    const unsigned G = gridDim.x * gridDim.y * gridDim.z;
    unsigned sum, cnt, mine, sp = 0u;
    for (;;) {
        sum = 0u; cnt = 0u; mine = 0u;
#pragma unroll
        for (unsigned j = 0; j < 16; ++j) { const unsigned c = xb_ld(&bar[XB_XCNT(j)]); sum += c; cnt += (c > 0u) ? 1u : 0u; mine = (j == x) ? c : mine; }
        if (sum == G) break;
        __builtin_amdgcn_s_sleep(1);
        if ((++sp & 255u) == 0u) { if (xb_ld(&bar[XB_TMO])) break; if (sp > XB_SPIN_CAP) { atomicAdd(&bar[XB_TMO], 1u); break; } }
    }
    nloc = mine > 0u ? mine : 1u; nx = cnt > 0u ? cnt : 1u;
}
__device__ __forceinline__ void xcd_barrier(const XcdBarrier& b) {
    asm volatile("s_waitcnt vmcnt(0)" ::: "memory");
    __syncthreads();
    if (threadIdx.x == 0) {
        unsigned* bar = b.bar;
        __builtin_amdgcn_s_waitcnt(0);
        unsigned nloc = b.st[0], nx = b.st[1];
        if (nloc == 0u) { xcd_barrier_complete(bar, b.x, nloc, nx); b.st[0] = nloc; b.st[1] = nx; }
        const unsigned old = xb_add(&bar[XB_XSUB(b.x)], 1u);
        const unsigned gen = old / nloc;
        if (old + 1u == (gen + 1u) * nloc) {
            __builtin_amdgcn_fence(__ATOMIC_RELEASE, "agent");
            asm volatile("s_waitcnt vmcnt(0)" ::: "memory");
            const unsigned og = xb_add(&bar[XB_TOP], 1u);
            const unsigned tg = og / nx;
            if (og + 1u == (tg + 1u) * nx) xb_add(&bar[XB_TOPGEN], 1u);
            else XB_SPIN(xb_ld(&bar[XB_TOPGEN]) == tg, bar);
            __builtin_amdgcn_fence(__ATOMIC_ACQUIRE, "agent");
            xb_add(&bar[XB_XGEN(b.x)], 1u);
            asm volatile("s_waitcnt vmcnt(0)" ::: "memory");
        } else {
            XB_SPIN(xb_ld(&bar[XB_XGEN(b.x)]) == gen, bar);
            __builtin_amdgcn_fence(__ATOMIC_ACQUIRE, "agent");
            asm volatile("s_waitcnt vmcnt(0)" ::: "memory");
        }
    }
    __syncthreads();
}

__device__ __forceinline__ void p0_transpose_item(const float* W, int ldw, bf16_t* WT, int ldo, int k0, int n0, LAS float* scr, int lane, const float* gain = nullptr) {
#pragma unroll
    for (int i = 0; i < 32; ++i) { const int kk = 2 * i + (lane >> 5); scr[kk * 33 + (lane & 31)] = W[(size_t)(k0 + kk) * ldw + n0 + (lane & 31)]; }
    LDS_WAIT(); asm volatile("" ::: "memory");
    const int c = lane & 7;
    f32x4 g0 = {1.f, 1.f, 1.f, 1.f}, g1 = {1.f, 1.f, 1.f, 1.f};
    if (gain) { g0 = *(const f32x4*)(gain + k0 + 8 * c); g1 = *(const f32x4*)(gain + k0 + 8 * c + 4); }
#pragma unroll
    for (int j = 0; j < 4; ++j) { const int n = (lane >> 3) + 8 * j; const LAS float* s = scr + (8 * c) * 33 + n;
        u32x4 o; o.x = cvt_pk_bf16(s[0 * 33] * g0.x, s[1 * 33] * g0.y); o.y = cvt_pk_bf16(s[2 * 33] * g0.z, s[3 * 33] * g0.w); o.z = cvt_pk_bf16(s[4 * 33] * g1.x, s[5 * 33] * g1.y); o.w = cvt_pk_bf16(s[6 * 33] * g1.z, s[7 * 33] * g1.w);
        *(u32x4*)(WT + (size_t)(n0 + n) * ldo + k0 + 8 * c) = o; }
    LDS_WAIT(); asm volatile("" ::: "memory");
}
__device__ __forceinline__ bool p0_mat(int& r, const float* W, int K, int N, bf16_t* WT, LAS float* scr, int lane) {
    const int nblk = N / 32, cnt = (K / 64) * nblk;
    if (r < cnt) { p0_transpose_item(W, N, WT, K, 64 * (r / nblk), 32 * (r % nblk), scr, lane); return true; }
    r -= cnt; return false;
}

constexpr int CW_BG = 64;
constexpr int BG_I_OUTE = (D / 64) * (D / 32), BG_I_UP = (D / 64) * (FF / 32), BG_I_DN = (FF / 64) * (D / 32), BG_I_INO = (D / 64) * (OIN / 32), BG_I_G = 16 * 2 * 50, BG_I_OUTO = (DR / 64) * (D / 32);
constexpr int BG_E1 = BG_I_OUTE / 16;
constexpr int BG_E2 = BG_E1 + BG_I_UP / 16;
constexpr int BG_E3 = BG_E2 + BG_I_DN / 16;
constexpr int BG_E4 = BG_E3 + BG_I_INO / 16;
constexpr int BG_E5 = BG_E4 + BG_I_G / 16;
constexpr int BG_E6 = BG_E5 + BG_I_OUTO / 16;
constexpr int BG_E7 = BG_E6 + BG_I_UP / 16;
constexpr int BG_E8 = BG_E7 + BG_I_DN / 16;
constexpr unsigned BG_NONE = 0xffffffffu;
typedef __attribute__((address_space(4))) const unsigned char* kargp2_t;
__device__ __forceinline__ const float* bg_in(int i) { kargp2_t kp = (kargp2_t)__builtin_amdgcn_kernarg_segment_ptr(); asm volatile("" : "+s"(kp)); return *(const float* const __attribute__((address_space(4)))*)(kp + 8 * i); }
__device__ __forceinline__ unsigned char* bg_ws() { kargp2_t kp = (kargp2_t)__builtin_amdgcn_kernarg_segment_ptr(); asm volatile("" : "+s"(kp)); return *(unsigned char* const __attribute__((address_space(4)))*)(kp + 208); }
struct BgItem { const float* W; bf16_t* WT; const float* gain; int ldw, ldo, k0, n0, perm; };
__device__ __forceinline__ BgItem bg_decode(int r, unsigned char* ws) {
    const float* W; bf16_t* WT; int K, N; const float* gain = nullptr;
    if (r < BG_I_OUTE) { W = bg_in(13); WT = (bf16_t*)(ws + WS_WOUTE); K = D; N = D; }
    else if ((r -= BG_I_OUTE) < BG_I_UP) { W = bg_in(23); WT = (bf16_t*)(ws + WS_WUP); K = D; N = FF; gain = bg_in(7); }
    else if ((r -= BG_I_UP) < BG_I_DN) { W = bg_in(24); WT = (bf16_t*)(ws + WS_WDN); K = FF; N = D; }
    else if ((r -= BG_I_DN) < BG_I_INO) { W = bg_in(14); WT = (bf16_t*)(ws + WS_WINO); K = D; N = OIN; gain = bg_in(6) + D; }
    else if ((r -= BG_I_INO) < BG_I_G) { const int blk = r / 100, rr = r % 100, gate = rr / 50, q = rr % 50;
        W = (gate ? bg_in(19) : bg_in(17)) + (size_t)blk * 320 * 320; WT = (bf16_t*)(ws + WS_GW) + (size_t)(blk * GWN) * GWK; K = -1 - gate; N = 320; r = q; }
    else if ((r -= BG_I_G) < BG_I_OUTO) { W = bg_in(22); WT = (bf16_t*)(ws + WS_WOUTO); K = DR; N = D; }
    else if ((r -= BG_I_OUTO) < BG_I_UP) { W = bg_in(23) + (size_t)D * FF; WT = (bf16_t*)(ws + WS_WUP) + (size_t)D * FF; K = D; N = FF; gain = bg_in(7) + D; }
    else { r -= BG_I_UP; W = bg_in(24) + (size_t)D * FF; WT = (bf16_t*)(ws + WS_WDN) + (size_t)D * FF; K = FF; N = D; }
    BgItem it; it.W = W; it.WT = WT; it.gain = gain; it.ldw = N; it.perm = K < 0 ? -K : 0;
    if (K < 0) { it.ldo = GWK; it.k0 = 64 * (r / 10); it.n0 = 32 * (r % 10); } else { const int nblk = N / 32; it.ldo = K; it.k0 = 64 * (r / nblk); it.n0 = 32 * (r % nblk); }
    return it;
}
__device__ __forceinline__ void bg_load(f32x4 (&v)[8], const BgItem& it, int lane) {
#pragma unroll
    for (int i = 0; i < 8; ++i) v[i] = __builtin_nontemporal_load((const f32x4*)(it.W + (size_t)(it.k0 + 8 * i + (lane >> 3)) * it.ldw + it.n0 + 4 * (lane & 7)));
}
template <bool NT> __device__ __forceinline__ void bg_finish(const f32x4 (&v)[8], const BgItem& it, LAS float* scr, int lane) {
#pragma unroll
    for (int i = 0; i < 8; ++i) { LAS float* d = scr + (8 * i + (lane >> 3)) * 33 + 4 * (lane & 7); d[0] = v[i].x; d[1] = v[i].y; d[2] = v[i].z; d[3] = v[i].w; }
    LDS_WAIT(); asm volatile("" ::: "memory");
    const int c = lane & 7;
    f32x4 g0 = {1.f, 1.f, 1.f, 1.f}, g1 = {1.f, 1.f, 1.f, 1.f};
    if (it.gain) { g0 = *(const f32x4*)(it.gain + it.k0 + 8 * c); g1 = *(const f32x4*)(it.gain + it.k0 + 8 * c + 4); }
#pragma unroll
    for (int j = 0; j < 4; ++j) { const int n = (lane >> 3) + 8 * j; const LAS float* sp = scr + (8 * c) * 33 + n;
        u32x4 o; o.x = cvt_pk_bf16(sp[0 * 33] * g0.x, sp[1 * 33] * g0.y); o.y = cvt_pk_bf16(sp[2 * 33] * g0.z, sp[3 * 33] * g0.w); o.z = cvt_pk_bf16(sp[4 * 33] * g1.x, sp[5 * 33] * g1.y); o.w = cvt_pk_bf16(sp[6 * 33] * g1.z, sp[7 * 33] * g1.w);
        const int nn_ = it.n0 + n;
        if (it.perm) {
            const int orow = 16 * (nn_ >> 3) + 4 * ((nn_ & 7) >> 1) + 2 * (it.perm - 1) + (nn_ & 1); const int kc = (it.k0 >> 3) + c;
            *(u32x4*)(it.WT + ((size_t)((orow >> 4) * 10 + (kc >> 2)) * 64 + (kc & 3) * 16 + (orow & 15)) * 8) = o; }
        else if (NT) __builtin_nontemporal_store(o, (u32x4*)(it.WT + (size_t)nn_ * it.ldo + it.k0 + 8 * c));
        else *(u32x4*)(it.WT + (size_t)nn_ * it.ldo + it.k0 + 8 * c) = o; }
    LDS_WAIT(); asm volatile("" ::: "memory");
}
__device__ __forceinline__ void bg_process(unsigned batch, LAS unsigned char* lds) {
    const int t_ = tid_l(); const int wave = __builtin_amdgcn_readfirstlane(t_ >> 6), lane = t_ & 63;
    LAS float* scr = (LAS float*)(lds + wave * 16384);
    unsigned char* ws = bg_ws();
    const int r0 = (int)batch * 16 + wave * 2;
    const BgItem a = bg_decode(r0, ws), b = bg_decode(r0 + 1, ws);
    f32x4 va[8], vb[8];
    bg_load(va, a, lane); bg_load(vb, b, lane);
    bg_finish<true>(va, a, scr, lane);
    bg_finish<true>(vb, b, scr, lane);
}
__device__ __forceinline__ unsigned bg_claim(unsigned* ctl, unsigned upto) {
    if (upto < (unsigned)BG_E8 && xb_ld(ctl + CW_BG) >= upto) return BG_NONE;
    const unsigned b = xb_add(ctl + CW_BG, 1u); return b < (unsigned)BG_E8 ? b : BG_NONE;
}
__device__ __forceinline__ void bg_drain(unsigned* ctl, unsigned deadline, LAS unsigned char* lds, volatile LAS unsigned* W5) {
    for (;;) {
        if (threadIdx.x == 0) { unsigned first = BG_NONE, n = 0u;
            const unsigned c = xb_ld(ctl + CW_BG);
            if (c < deadline) { n = (c + 2u <= deadline) ? 2u : 1u; first = xb_add(ctl + CW_BG, n); if (first >= (unsigned)BG_E8) { first = BG_NONE; n = 0u; } else if (first + n > (unsigned)BG_E8) n = 1u; }
            W5[5] = first; W5[7] = n; }
        __syncthreads();
        const unsigned bb = W5[5], nb = W5[7];
        if (bb == BG_NONE) break;
        bg_process(bb, lds);
        if (nb > 1u) { __syncthreads(); bg_process(bb + 1u, lds); }
        __syncthreads();
    }
    __syncthreads();
}
__device__ __forceinline__ void xcd_barrier_bg(const XcdBarrier& b, unsigned* ctl, LAS unsigned char* lds, volatile LAS unsigned* W5) {
    asm volatile("s_waitcnt vmcnt(0)" ::: "memory");
    __syncthreads();
    if (threadIdx.x == 0) {
        unsigned* bar = b.bar;
        __builtin_amdgcn_s_waitcnt(0);
        unsigned nloc = b.st[0], nx = b.st[1];
        if (nloc == 0u) { xcd_barrier_complete(bar, b.x, nloc, nx); b.st[0] = nloc; b.st[1] = nx; }
        const unsigned old = xb_add(&bar[XB_XSUB(b.x)], 1u);
        const unsigned gen = old / nloc;
        unsigned leader = 0u, tg = 0u, lastx = 0u;
        if (old + 1u == (gen + 1u) * nloc) {
            leader = 1u;
            __builtin_amdgcn_fence(__ATOMIC_RELEASE, "agent");
            asm volatile("s_waitcnt vmcnt(0)" ::: "memory");
            const unsigned og = xb_add(&bar[XB_TOP], 1u);
            tg = og / nx;
            if (og + 1u == (tg + 1u) * nx) { xb_add(&bar[XB_TOPGEN], 1u); lastx = 1u; }
        }
        W5[0] = leader; W5[1] = gen; W5[2] = tg; W5[3] = lastx;
    }
    __syncthreads();
    const unsigned leader = W5[0], gen = W5[1], tg = W5[2], lastx = W5[3];
    for (unsigned it = 0;; ++it) {
        if (threadIdx.x == 0) {
            unsigned* bar = b.bar;
            bool done = leader ? (lastx != 0u || xb_ld(&bar[XB_TOPGEN]) != tg) : (xb_ld(&bar[XB_XGEN(b.x)]) != gen);
            if (!done && (it & 255u) == 255u) { if (xb_ld(&bar[XB_TMO])) done = true; else if (it > XB_SPIN_CAP) { atomicAdd(&bar[XB_TMO], 1u); done = true; } }
            W5[4] = done ? 1u : 0u;
            unsigned cl = BG_NONE;
            if (!done && !leader && W5[6] == 0u) { cl = bg_claim(ctl, (unsigned)BG_E8); if (cl == BG_NONE) W5[6] = 1u; }
            W5[5] = cl;
        }
        __syncthreads();
        if (W5[4]) break;
        const unsigned bb = W5[5];
        if (bb != BG_NONE) bg_process(bb, lds); else __builtin_amdgcn_s_sleep(8);
        __syncthreads();
    }
    if (threadIdx.x == 0) {
        unsigned* bar = b.bar;
        __builtin_amdgcn_fence(__ATOMIC_ACQUIRE, "agent");
        if (leader) xb_add(&bar[XB_XGEN(b.x)], 1u);
        asm volatile("s_waitcnt vmcnt(0)" ::: "memory");
    }
    __syncthreads();
}

template <bool FINAL> __device__ __forceinline__ void rms_phase(const float* srcP, const float* srcS, const float* part, float* hout, const float* gain, bf16_t* XN, float* outf, int gw, int NGW, int lane) {
    f32x4 g4v[16];
#pragma unroll
    for (int j = 0; j < 16; ++j) g4v[j] = ((const f32x4*)gain)[lane + 64 * j];
    for (int m = gw; m < M; m += NGW) {
        const float* src = (m < MP) ? srcP + (size_t)m * D : srcS + (size_t)(m - MP) * D;
        const f32x4* xr = (const f32x4*)src + lane;
        f32x4 v[16]; float ss = 0.f;
#pragma unroll
        for (int j = 0; j < 16; ++j) v[j] = xr[64 * j];
        if (part != nullptr && m >= MP) {
#pragma unroll
            for (int g = 0; g < 4; ++g) { const f32x4* pr = (const f32x4*)(part + ((size_t)g * MS + (m - MP)) * D) + lane;
#pragma unroll
                for (int j = 0; j < 16; ++j) v[j] += pr[64 * j]; }
            if (hout != nullptr) {
#pragma unroll
                for (int j = 0; j < 16; ++j) ((f32x4*)(hout + (size_t)m * D))[lane + 64 * j] = v[j]; }
        }
#pragma unroll
        for (int j = 0; j < 16; ++j) ss += (v[j].x * v[j].x + v[j].y * v[j].y) + (v[j].z * v[j].z + v[j].w * v[j].w);
        ss = wave_sum(ss);
        const float rstd = __builtin_amdgcn_rsqf(ss * (1.0f / D) + EPS);
#pragma unroll
        for (int j = 0; j < 16; ++j) { const f32x4 o = v[j] * rstd * g4v[j];
            if (FINAL) __builtin_nontemporal_store(o, (f32x4*)(outf + (size_t)m * D) + lane + 64 * j);
            else { u32x2 w; w.x = cvt_pk_bf16(o.x, o.y); w.y = cvt_pk_bf16(o.z, o.w); ((u32x2*)(XN + (size_t)m * D))[lane + 64 * j] = w; } }
    }
}

__device__ __forceinline__ void mini_norm_phase(const float* xs, const bf16_t* part, bf16_t* HB, const float* SSP, float* RSTD, int gw, int NGW, int lane, int vcu, int G, int tid) {
    for (int m = MP + gw; m < M; m += NGW) {
        f32x4 v[16]; float ss = 0.f;
        if (xs) { const f32x4* xr = (const f32x4*)(xs + (size_t)(m - MP) * D) + lane;
#pragma unroll
            for (int j = 0; j < 16; ++j) v[j] = xr[64 * j]; }
        else { const u32x2* hr = (const u32x2*)(HB + (size_t)m * D) + lane;
#pragma unroll
            for (int j = 0; j < 16; ++j) { const u32x2 w = hr[64 * j]; v[j] = (f32x4){bflo(w.x), bfhi(w.x), bflo(w.y), bfhi(w.y)}; } }
#pragma unroll
        for (int g = 0; g < 4; ++g) { const u32x2* pr = (const u32x2*)(part + ((size_t)g * MS + (m - MP)) * D) + lane;
#pragma unroll
            for (int j = 0; j < 16; ++j) { const u32x2 q = pr[64 * j]; v[j] += (f32x4){bflo(q.x), bfhi(q.x), bflo(q.y), bfhi(q.y)}; } }
#pragma unroll
        for (int j = 0; j < 16; ++j) { u32x2 w; w.x = cvt_pk_bf16(v[j].x, v[j].y); w.y = cvt_pk_bf16(v[j].z, v[j].w); ((u32x2*)(HB + (size_t)m * D))[lane + 64 * j] = w;
            const float r0 = bflo(w.x), r1 = bfhi(w.x), r2 = bflo(w.y), r3 = bfhi(w.y); ss += (r0 * r0 + r1 * r1) + (r2 * r2 + r3 * r3); }
        ss = wave_sum(ss);
        if (lane == 0) RSTD[m] = __builtin_amdgcn_rsqf(ss * (1.0f / D) + EPS);
    }
    for (int r = vcu * 512 + tid; r < MP; r += G * 512) { const f32x4* sp = (const f32x4*)(SSP + (size_t)r * 64); float ss = 0.f;
#pragma unroll
        for (int j = 0; j < 16; ++j) { const f32x4 q = sp[j]; ss += (q.x + q.y) + (q.z + q.w); }
        RSTD[r] = __builtin_amdgcn_rsqf(ss * (1.0f / D) + EPS); }
}
__device__ __forceinline__ void final_norm_phase(const bf16_t* HB, const bf16_t* part, const float* gain, float* outf, int gw, int NGW, int lane) {
    f32x4 g4v[16];
#pragma unroll
    for (int j = 0; j < 16; ++j) g4v[j] = ((const f32x4*)gain)[lane + 64 * j];
    for (int m = gw; m < M; m += NGW) {
        const u32x2* hr = (const u32x2*)(HB + (size_t)m * D) + lane; f32x4 v[16]; float ss = 0.f;
#pragma unroll
        for (int j = 0; j < 16; ++j) { const u32x2 w = hr[64 * j]; v[j] = (f32x4){bflo(w.x), bfhi(w.x), bflo(w.y), bfhi(w.y)}; }
        if (m >= MP) {
#pragma unroll
            for (int g = 0; g < 4; ++g) { const u32x2* pr = (const u32x2*)(part + ((size_t)g * MS + (m - MP)) * D) + lane;
#pragma unroll
                for (int j = 0; j < 16; ++j) { const u32x2 q = pr[64 * j]; v[j] += (f32x4){bflo(q.x), bfhi(q.x), bflo(q.y), bfhi(q.y)}; } } }
#pragma unroll
        for (int j = 0; j < 16; ++j) ss += (v[j].x * v[j].x + v[j].y * v[j].y) + (v[j].z * v[j].z + v[j].w * v[j].w);
        ss = wave_sum(ss);
        const float rstd = __builtin_amdgcn_rsqf(ss * (1.0f / D) + EPS);
#pragma unroll
        for (int j = 0; j < 16; ++j) __builtin_nontemporal_store(v[j] * rstd * g4v[j], (f32x4*)(outf + (size_t)m * D) + lane + 64 * j);
    }
}

namespace mix {
typedef short s16x4 __attribute__((ext_vector_type(4)));
typedef short s16x8 __attribute__((ext_vector_type(8)));
constexpr int PQ = 136, PV = 72, PVR = 40, PLF = 132;
constexpr int OFF_LF = 0;
constexpr int OFF_SEG = 33792;
constexpr int IMG_Q = 0, IMG_K = 17408, IMG_V = 34816, IMG_D = 39936, IMG_BYTES = 40448;
constexpr int OFF_IMG = 0;
constexpr int OFF_ATT = OFF_IMG + 2 * IMG_BYTES;
constexpr int OFF_ST = OFF_ATT + 2 * 9216;
constexpr int OFF_END = OFF_ST + 2 * 8704;
static_assert(OFF_END <= RING_BYTES && OFF_SEG + 2048 <= RING_BYTES, "mixer LDS");
constexpr int NCHUNK = 2 * (SEQ / 64) + DECB;

struct Raw { u32x4 q0, q1, f0, f1; f32x4 rc[4]; };
__device__ __forceinline__ void prep_decode(int u, int& row0, int& L, int& pos0, int& hd, int& cidx) {
    cidx = u / 24; hd = u % 24;
    if (cidx < 256) { row0 = cidx * 64; L = 64; pos0 = (cidx & 127) * 64; } else { row0 = MP + (cidx - 256) * DECS; L = DECS; pos0 = PAST; }
}
__device__ __forceinline__ void prep_load(Raw& r, const bf16_t* PROJ, const f32x2* ROT, int row0, int L, int pos0, int hd, int el, int kc) {
    const int qcol = hd < 16 ? hd * 128 : 8192 + (hd - 16) * 128, fcol = hd < 16 ? 2048 + hd * 128 : 9216 + (hd - 16) * 128;
    const u32x4 z4 = {0u, 0u, 0u, 0u};
    if (el < L) { const bf16_t* prow = PROJ + (size_t)(row0 + el) * EIN;
        r.q0 = *(const u32x4*)(prow + qcol + kc); r.q1 = *(const u32x4*)(prow + qcol + 64 + kc); r.f0 = *(const u32x4*)(prow + fcol + kc); r.f1 = *(const u32x4*)(prow + fcol + 64 + kc);
        if (hd >= 16) { const f32x4* rp = (const f32x4*)(ROT + (size_t)(pos0 + el) * 64 + kc); r.rc[0] = rp[0]; r.rc[1] = rp[1]; r.rc[2] = rp[2]; r.rc[3] = rp[3]; } }
    else { r.q0 = z4; r.q1 = z4; r.f0 = z4; r.f1 = z4; }
}
__device__ __forceinline__ u32x4 pack8(const float* x) { u32x4 w; w.x = cvt_pk_bf16(x[0], x[1]); w.y = cvt_pk_bf16(x[2], x[3]); w.z = cvt_pk_bf16(x[4], x[5]); w.w = cvt_pk_bf16(x[6], x[7]); return w; }
__device__ __forceinline__ void sig2(float x, float& s, float& ns) { const float e = fexp(-fabsf(x)), r = frcp(1.0f + e), t = e * r; s = x >= 0.f ? r : t; ns = x >= 0.f ? t : r; }
__device__ __forceinline__ void prep_unit(LAS unsigned char* lds, const Raw& r, bf16_t* PROJ, const float* LB, float* DECB, int row0, int L, int hd, int cidx, int tid) {
    const int el = tid >> 3, kc = (tid & 7) * 8; const bool valid = el < L;
    const unsigned qw[8] = {r.q0.x, r.q0.y, r.q0.z, r.q0.w, r.q1.x, r.q1.y, r.q1.z, r.q1.w};
    const unsigned fw[8] = {r.f0.x, r.f0.y, r.f0.z, r.f0.w, r.f1.x, r.f1.y, r.f1.z, r.f1.w};
    float qs[16], om[16];
    if (hd < 16) {
        LAS float* LF = (LAS float*)(lds + OFF_LF); LAS float* SEG = (LAS float*)(lds + OFF_SEG);
        const int qcol = hd * 128, fcol = 2048 + hd * 128;
        float lf[16];
#pragma unroll
        for (int i = 0; i < 8; ++i)
#pragma unroll
            for (int hh = 0; hh < 2; ++hh) { const int e = 2 * i + hh; const float q = hh ? bfhi(qw[i]) : bflo(qw[i]); const float fraw = hh ? bfhi(fw[i]) : bflo(fw[i]);
                const float lb = LB[hd * 128 + (e >> 3) * 64 + kc + (e & 7)];
                float sg, nsg, sq, nsq; sig2(fraw, sg, nsg); sig2(q, sq, nsq);
                const float f = lb + (1.0f - lb) * sg;
                lf[e] = valid ? flog(f) : 0.f; om[e] = (1.0f - lb) * nsg; qs[e] = q * sq; }
#pragma unroll
        for (int c = 0; c < 2; ++c) { *(LAS f32x4*)(LF + el * PLF + c * 64 + kc) = (f32x4){lf[c * 8 + 0], lf[c * 8 + 1], lf[c * 8 + 2], lf[c * 8 + 3]};
            *(LAS f32x4*)(LF + el * PLF + c * 64 + kc + 4) = (f32x4){lf[c * 8 + 4], lf[c * 8 + 5], lf[c * 8 + 6], lf[c * 8 + 7]}; }
        __syncthreads();
        { const int k = tid & 127, sg = tid >> 7; float run = 0.f;
#pragma unroll
          for (int i = 0; i < 16; ++i) { run += LF[(sg * 16 + i) * PLF + k]; LF[(sg * 16 + i) * PLF + k] = run; }
          SEG[sg * 128 + k] = run; }
        __syncthreads();
        if (tid < 128) DECB[(size_t)(cidx * 16 + hd) * 128 + tid] = fexp((SEG[tid] + SEG[128 + tid]) + (SEG[256 + tid] + SEG[384 + tid]));
        const int sgl = el >> 4;
        if (valid) {
            bf16_t* prow = PROJ + (size_t)(row0 + el) * EIN;
#pragma unroll
            for (int c = 0; c < 2; ++c) {
                float bb[8];
#pragma unroll
                for (int j4 = 0; j4 < 2; ++j4) { const int k = c * 64 + kc + 4 * j4; f32x4 b = *(const LAS f32x4*)(LF + el * PLF + k);
                    const f32x4 s0 = *(const LAS f32x4*)(SEG + k), s1 = *(const LAS f32x4*)(SEG + 128 + k), s2 = *(const LAS f32x4*)(SEG + 256 + k);
                    if (sgl > 0) b += s0; if (sgl > 1) b += s1; if (sgl > 2) b += s2;
                    bb[4 * j4 + 0] = b.x; bb[4 * j4 + 1] = b.y; bb[4 * j4 + 2] = b.z; bb[4 * j4 + 3] = b.w; }
                float qi[8], ki[8];
#pragma unroll
                for (int j = 0; j < 8; ++j) { qi[j] = qs[c * 8 + j] * fexp(bb[j]); ki[j] = om[c * 8 + j] * fexp(-bb[j]); }
                *(u32x4*)(prow + qcol + c * 64 + kc) = pack8(qi); *(u32x4*)(prow + fcol + c * 64 + kc) = pack8(ki); }
        }
        __syncthreads();
    } else if (valid) {
        const int h = hd - 16; const int qcol = 8192 + h * 128, fcol = 9216 + h * 128;
        const float lg = flog(1.0f - __builtin_amdgcn_exp2f(-5.0f - (float)h));
        const float cs[16] = {r.rc[0].x, r.rc[0].y, r.rc[0].z, r.rc[0].w, r.rc[1].x, r.rc[1].y, r.rc[1].z, r.rc[1].w, r.rc[2].x, r.rc[2].y, r.rc[2].z, r.rc[2].w, r.rc[3].x, r.rc[3].y, r.rc[3].z, r.rc[3].w};
        const float e1 = fexp((float)(el + 1) * lg), e2 = fexp(-(float)(el + 1) * lg) * 0.08838834764831845f;
#pragma unroll
        for (int i = 0; i < 4; ++i)
#pragma unroll
            for (int hh = 0; hh < 2; ++hh) { const int j = 2 * i + hh; const float co = cs[2 * j], si = cs[2 * j + 1];
                const float q1 = hh ? bfhi(qw[i]) : bflo(qw[i]), q2 = hh ? bfhi(qw[4 + i]) : bflo(qw[4 + i]);
                const float k1 = hh ? bfhi(fw[i]) : bflo(fw[i]), k2 = hh ? bfhi(fw[4 + i]) : bflo(fw[4 + i]);
                qs[j] = (q1 * co - q2 * si) * e1; qs[8 + j] = (q2 * co + q1 * si) * e1; om[j] = (k1 * co - k2 * si) * e2; om[8 + j] = (k2 * co + k1 * si) * e2; }
        bf16_t* prow = PROJ + (size_t)(row0 + el) * EIN;
#pragma unroll
        for (int c = 0; c < 2; ++c) { *(u32x4*)(prow + qcol + c * 64 + kc) = pack8(qs + c * 8); *(u32x4*)(prow + fcol + c * 64 + kc) = pack8(om + c * 8); }
    }
}

struct RawC { u32x4 q0, q1, f0, f1, v; float d; };
template <int KIND, bool SAMPLE>
__device__ __forceinline__ void chain(LAS unsigned char* lds, const bf16_t* PROJ, bf16_t* ORAW, const float* DECB,
                                      int row0, int nsteps, int cidx0, int sb0, int sbs, int h, int vs, const float* S0b, float* Sob) {
    constexpr int DV = KIND == 0 ? 128 : 256; constexpr size_t sstride = (size_t)128 * DV * (KIND == 0 ? 16 : 8);
    constexpr int L = SAMPLE ? DECS : 64;
    const int tid = tid_l(), wid = __builtin_amdgcn_readfirstlane(tid >> 6), lane = tid & 63, fr = lane & 15, fq = lane >> 4;
    const int qcol = KIND == 0 ? h * 128 : 8192 + h * 128;
    const int fcol = KIND == 0 ? 2048 + h * 128 : 9216 + h * 128;
    const int vcol = KIND == 0 ? 4096 + h * 128 + vs * 32 : 10240 + h * 256 + vs * 32;
    const int ocol = KIND == 0 ? h * 128 + vs * 32 : 2048 + h * 256 + vs * 32;
    const size_t hoff = (size_t)h * 128 * DV;
    const int el = tid >> 3, kc = (tid & 7) * 8;
    const bool valid = el < L;
    const int vl = tid >> 2, vq = tid & 3;
    const bool vvalid = (tid < 256) && (vl < L);
    float decc = 1.f;
    if (KIND == 1) decc = fexp((float)L * flog(1.0f - __builtin_amdgcn_exp2f(-5.0f - (float)h)));
    const u32x4 z4 = {0u, 0u, 0u, 0u};
#define CH_ROW(s) (SAMPLE ? MP + (sb0 + sbs * (s)) * DECS : row0 + (s) * 64)
#define CH_LOAD(R, s) do { const int rb_ = CH_ROW(s); const bf16_t* prow = PROJ + (size_t)(rb_ + el) * EIN; \
        if (valid) { R.q0 = *(const u32x4*)(prow + qcol + kc); R.q1 = *(const u32x4*)(prow + qcol + 64 + kc); R.f0 = *(const u32x4*)(prow + fcol + kc); R.f1 = *(const u32x4*)(prow + fcol + 64 + kc); } \
        else { R.q0 = z4; R.q1 = z4; R.f0 = z4; R.f1 = z4; } \
        if (vvalid) R.v = *(const u32x4*)(PROJ + (size_t)(rb_ + vl) * EIN + vcol + vq * 8); else R.v = z4; \
        R.d = 1.f; if (KIND == 0 && tid < 128) R.d = DECB[(size_t)((SAMPLE ? 256 + sb0 + sbs * (s) : cidx0 + (s)) * 16 + h) * 128 + tid]; } while (0)
#define CH_IMAGE(R, b) do { LAS unsigned char* im_ = lds + OFF_IMG + (b) * IMG_BYTES; \
        if (!SAMPLE || valid) { *(LAS u32x4*)(im_ + IMG_Q + (el * PQ + kc) * 2) = R.q0; *(LAS u32x4*)(im_ + IMG_Q + (el * PQ + 64 + kc) * 2) = R.q1; \
        *(LAS u32x4*)(im_ + IMG_K + (el * PQ + kc) * 2) = R.f0; *(LAS u32x4*)(im_ + IMG_K + (el * PQ + 64 + kc) * 2) = R.f1; } \
        if (tid < 128) ((LAS float*)(im_ + IMG_D))[tid] = KIND == 0 ? R.d : decc; \
        if (tid < 256 && (!SAMPLE || vl < L)) *(LAS u32x4*)(im_ + IMG_V + (vl * PVR + vq * 8) * 2) = R.v; } while (0)
    f32x4 sacc[2], snx[2];
#define CH_STATE_LOAD(dst, s) do { const float* sp_ = S0b + (size_t)(sb0 + sbs * (s)) * sstride + hoff; \
        _Pragma("unroll") for (int vt = 0; vt < 2; ++vt) _Pragma("unroll") for (int r = 0; r < 4; ++r) dst[vt][r] = sp_[(size_t)(wid * 16 + 4 * fq + r) * DV + vs * 32 + vt * 16 + fr]; } while (0)
#define CH_ST_WRITE(buf) do { _Pragma("unroll") for (int vt = 0; vt < 2; ++vt) { u32x2 w; w.x = cvt_pk_bf16(sacc[vt][0], sacc[vt][1]); w.y = cvt_pk_bf16(sacc[vt][2], sacc[vt][3]); \
        *(LAS u32x2*)(lds + OFF_ST + (buf) * 8704 + ((vt * 16 + fr) * PQ + wid * 16 + 4 * fq) * 2) = w; } } while (0)
    if (SAMPLE) { CH_STATE_LOAD(sacc, 0); } else { sacc[0] = (f32x4){0.f, 0.f, 0.f, 0.f}; sacc[1] = sacc[0]; }
    struct Frag { bf16x8 kof[2], vfr[2][2], qfr[4]; f32x4 dec; };
    auto prep = [&](const int s1, Frag& F) __attribute__((always_inline)) {
        LAS unsigned char* im = lds + OFF_IMG + (s1 & 1) * IMG_BYTES;
        const LAS bf16_t* QIN = (const LAS bf16_t*)(im + IMG_Q); const LAS bf16_t* KIN = (const LAS bf16_t*)(im + IMG_K); const LAS bf16_t* VR = (const LAS bf16_t*)(im + IMG_V); const LAS float* DEC = (const LAS float*)(im + IMG_D);
        LAS bf16_t* ATT = (LAS bf16_t*)(lds + OFF_ATT + (s1 & 1) * 9216);
        { const int q = fr >> 2, p = fr & 3;
#pragma unroll
          for (int ll = 0; ll < (SAMPLE ? 1 : 2); ++ll) {
            const s16x4 lo = __builtin_amdgcn_ds_read_tr16_b64_v4i16((LAS s16x4*)(KIN + (32 * ll + 8 * fq + q) * PQ + wid * 16 + 4 * p));
            const s16x4 hi = __builtin_amdgcn_ds_read_tr16_b64_v4i16((LAS s16x4*)(KIN + (32 * ll + 8 * fq + 4 + q) * PQ + wid * 16 + 4 * p));
            const s16x8 w = {lo[0], lo[1], lo[2], lo[3], hi[0], hi[1], hi[2], hi[3]};
            F.kof[ll] = __builtin_bit_cast(bf16x8, w);
#pragma unroll
            for (int vt = 0; vt < 2; ++vt) {
              const s16x4 vlo = __builtin_amdgcn_ds_read_tr16_b64_v4i16((LAS s16x4*)(VR + (32 * ll + 8 * fq + q) * PVR + vt * 16 + 4 * p));
              const s16x4 vhi = __builtin_amdgcn_ds_read_tr16_b64_v4i16((LAS s16x4*)(VR + (32 * ll + 8 * fq + 4 + q) * PVR + vt * 16 + 4 * p));
              const s16x8 vw = {vlo[0], vlo[1], vlo[2], vlo[3], vhi[0], vhi[1], vhi[2], vhi[3]};
              F.vfr[vt][ll] = __builtin_bit_cast(bf16x8, vw); } } }
        F.dec = *(const LAS f32x4*)(DEC + wid * 16 + 4 * fq);
        const int lt = wid & 3, hi = wid >> 2;
        const int mtA = hi ? (lt == 1 ? 1 : 2) : 0, mtB = hi ? 3 : 1;
        const bool live = !(SAMPLE && lt >= 2);
        const bool hasA = live && !(hi && lt == 0), hasB = live && (hi ? (lt == 3) : (lt >= 2));
        if (live)
#pragma unroll
        for (int kk = 0; kk < 4; ++kk) F.qfr[kk] = *(const LAS bf16x8*)(QIN + (lt * 16 + fr) * PQ + kk * 32 + 8 * fq);
        const int l = lt * 16 + fr;
        if (hasA) { f32x4 d = {0.f, 0.f, 0.f, 0.f};
#pragma unroll
            for (int kk = 0; kk < 4; ++kk) { const bf16x8 a = *(const LAS bf16x8*)(KIN + (mtA * 16 + fr) * PQ + kk * 32 + 8 * fq); d = __builtin_amdgcn_mfma_f32_16x16x32_bf16(a, F.qfr[kk], d, 0, 0, 0); }
            const int m0 = mtA * 16 + 4 * fq; float x[4];
#pragma unroll
            for (int r = 0; r < 4; ++r) x[r] = (m0 + r <= l) ? d[r] : 0.f;
            u32x2 w; w.x = cvt_pk_bf16(x[0], x[1]); w.y = cvt_pk_bf16(x[2], x[3]); *(LAS u32x2*)(ATT + l * PV + m0) = w; }
        if (hasB) { f32x4 d = {0.f, 0.f, 0.f, 0.f};
#pragma unroll
            for (int kk = 0; kk < 4; ++kk) { const bf16x8 a = *(const LAS bf16x8*)(KIN + (mtB * 16 + fr) * PQ + kk * 32 + 8 * fq); d = __builtin_amdgcn_mfma_f32_16x16x32_bf16(a, F.qfr[kk], d, 0, 0, 0); }
            const int m0 = mtB * 16 + 4 * fq; float x[4];
#pragma unroll
            for (int r = 0; r < 4; ++r) x[r] = (m0 + r <= l) ? d[r] : 0.f;
            u32x2 w; w.x = cvt_pk_bf16(x[0], x[1]); w.y = cvt_pk_bf16(x[2], x[3]); *(LAS u32x2*)(ATT + l * PV + m0) = w; }
    };
    auto interval = [&](const int s, Frag& Fc, Frag& Fn, RawC& R) __attribute__((always_inline)) {
        if (!(SAMPLE && (wid & 3) >= 2)) {
            const int vt = wid >> 2, lt = wid & 3; const int v = vt * 16 + fr;
            const LAS bf16_t* ATT = (const LAS bf16_t*)(lds + OFF_ATT + (s & 1) * 9216);
            f32x4 d = {0.f, 0.f, 0.f, 0.f};
#pragma unroll
            for (int mm = 0; mm < 2; ++mm) if (mm == 0 || lt >= 2) {
                const bf16x8 a = vt ? Fc.vfr[1][mm] : Fc.vfr[0][mm];
                const bf16x8 b = *(const LAS bf16x8*)(ATT + (lt * 16 + fr) * PV + mm * 32 + 8 * fq);
                d = __builtin_amdgcn_mfma_f32_16x16x32_bf16(a, b, d, 0, 0, 0); }
            const LAS bf16_t* STc = (const LAS bf16_t*)(lds + OFF_ST + (s & 1) * 8704);
#pragma unroll
            for (int kk = 0; kk < 4; ++kk) {
                const bf16x8 a = *(const LAS bf16x8*)(STc + v * PQ + kk * 32 + 8 * fq);
                d = __builtin_amdgcn_mfma_f32_16x16x32_bf16(a, Fc.qfr[kk], d, 0, 0, 0); }
            const int l = lt * 16 + fr;
            if (l < L) { u32x2 w; w.x = cvt_pk_bf16(d[0], d[1]); w.y = cvt_pk_bf16(d[2], d[3]); *(u32x2*)(ORAW + (size_t)(CH_ROW(s) + l) * D + ocol + vt * 16 + 4 * fq) = w; }
        }
#pragma unroll
        for (int vt = 0; vt < 2; ++vt) {
#pragma unroll
            for (int ll = 0; ll < (SAMPLE ? 1 : 2); ++ll) sacc[vt] = __builtin_amdgcn_mfma_f32_16x16x32_bf16(Fc.kof[ll], Fc.vfr[vt][ll], sacc[vt], 0, 0, 0);
            sacc[vt] = sacc[vt] * Fc.dec; }
        if (SAMPLE) {
            float* so = Sob + (size_t)(sb0 + sbs * s) * sstride + hoff;
#pragma unroll
            for (int vt = 0; vt < 2; ++vt)
#pragma unroll
                for (int r = 0; r < 4; ++r) so[(size_t)(wid * 16 + 4 * fq + r) * DV + vs * 32 + vt * 16 + fr] = sacc[vt][r];
            if (s + 1 < nsteps) { sacc[0] = snx[0]; sacc[1] = snx[1]; if (s + 2 < nsteps) CH_STATE_LOAD(snx, s + 2); }
        }
        if (s + 1 < nsteps) { CH_ST_WRITE((s + 1) & 1); prep(s + 1, Fn); }
        if (s + 2 < nsteps) { CH_IMAGE(R, s & 1); if (s + 4 < nsteps) CH_LOAD(R, s + 4); }
        __syncthreads();
    };
    for (int i = tid; i < 2 * 9216 / 16; i += 512) *(LAS u32x4*)(lds + OFF_ATT + i * 16) = (u32x4){0u, 0u, 0u, 0u};
    RawC RA, RB;
    CH_LOAD(RA, 0);
    if (nsteps > 1) CH_LOAD(RB, 1);
    CH_IMAGE(RA, 0);
    if (nsteps > 1) CH_IMAGE(RB, 1);
    if (nsteps > 2) CH_LOAD(RA, 2);
    if (nsteps > 3) CH_LOAD(RB, 3);
    CH_ST_WRITE(0);
    if (SAMPLE && nsteps > 1) CH_STATE_LOAD(snx, 1);
    __syncthreads();
    Frag FA, FB;
    prep(0, FA);
    __syncthreads();
    for (int s = 0; s < nsteps; s += 2) { interval(s, FA, FB, RA); if (s + 1 < nsteps) interval(s + 1, FB, FA, RB); }
    if (!SAMPLE) {
#pragma unroll
        for (int vt = 0; vt < 2; ++vt)
#pragma unroll
            for (int r = 0; r < 4; ++r) Sob[hoff + (size_t)(wid * 16 + 4 * fq + r) * DV + vs * 32 + vt * 16 + fr] = sacc[vt][r];
    }
#undef CH_ROW
#undef CH_LOAD
#undef CH_IMAGE
#undef CH_STATE_LOAD
#undef CH_ST_WRITE
}
}

__device__ __forceinline__ void headnorm_phase(const bf16_t* ORAW, const bf16_t* PROJ, const float* gA, const float* gB, bf16_t* MIXO, int gw, int NGW, int lane) {
    f32x4 nv[8][2];
#pragma unroll
    for (int j = 0; j < 8; ++j) { const float* gn = (j < 4 ? gA : gB) + 8 * lane + 512 * (j & 3); nv[j][0] = *(const f32x4*)gn; nv[j][1] = *(const f32x4*)(gn + 4); }
    for (int m = gw; m < M; m += NGW) {
        const u32x4* orow = (const u32x4*)(ORAW + (size_t)m * D) + lane;
        const bf16_t* prow = PROJ + (size_t)m * EIN;
        u32x4* mrow = (u32x4*)(MIXO + (size_t)m * D) + lane;
#pragma unroll
        for (int j = 0; j < 8; ++j) {
            const u32x4 ow = orow[64 * j]; float o[8] = {bflo(ow.x), bfhi(ow.x), bflo(ow.y), bfhi(ow.y), bflo(ow.z), bfhi(ow.z), bflo(ow.w), bfhi(ow.w)};
            const int c = 8 * lane + 512 * (j & 3);
            const u32x4 gw4 = *(const u32x4*)(prow + (j < 4 ? 6144 : 12288) + c); const f32x4 n0 = nv[j][0], n1 = nv[j][1];
            const float g[8] = {bflo(gw4.x), bfhi(gw4.x), bflo(gw4.y), bfhi(gw4.y), bflo(gw4.z), bfhi(gw4.z), bflo(gw4.w), bfhi(gw4.w)}; const float nn[8] = {n0.x, n0.y, n0.z, n0.w, n1.x, n1.y, n1.z, n1.w};
            float rs;
            if (j < 4) { float ss = 0.f;
#pragma unroll
                for (int e = 0; e < 8; ++e) ss += o[e] * o[e];
                ss = row16_sum(ss);
                rs = __builtin_amdgcn_rsqf(ss * (1.0f / 128.0f) + EPS);
            } else { float sm = 0.f;
#pragma unroll
                for (int e = 0; e < 8; ++e) sm += o[e];
                sm = row16_sum(sm); sm += __shfl_xor(sm, 16);
                const float mu = sm * (1.0f / 256.0f); float var = 0.f;
#pragma unroll
                for (int e = 0; e < 8; ++e) { o[e] -= mu; var += o[e] * o[e]; }
                var = row16_sum(var); var += __shfl_xor(var, 16);
                rs = __builtin_amdgcn_rsqf(var * (1.0f / 256.0f) + EPS);
            }
            float r[8];
#pragma unroll
            for (int e = 0; e < 8; ++e) r[e] = o[e] * rs * nn[e] * g[e] * sigm(g[e]);
            u32x4 w; w.x = cvt_pk_bf16(r[0], r[1]); w.y = cvt_pk_bf16(r[2], r[3]); w.z = cvt_pk_bf16(r[4], r[5]); w.w = cvt_pk_bf16(r[6], r[7]);
            mrow[64 * j] = w; }
    }
}

__device__ __forceinline__ void conv_phase(const bf16_t* PROJ2, const float* sconv, const float* cw, const float* cb, bf16_t* XC, float* out, int gw, int NGW, int lane) {
    if (gw == 0) { for (int i = lane; i < 4096; i += 64) XC[(size_t)M * DR + i] = 0; }
    for (int u = gw; u < (M / 32) * 10; u += NGW) {
        const int strip = u / 10, cg = u % 10; const int r0 = strip * 32, c0 = cg * 512 + lane * 8;
        float w[4][8], bias[8], h3[8], h2[8], h1[8];
#pragma unroll
        for (int j = 0; j < 4; ++j) { const f32x4 a = *(const f32x4*)(cw + j * DR + c0), b = *(const f32x4*)(cw + j * DR + c0 + 4);
            w[j][0] = a.x; w[j][1] = a.y; w[j][2] = a.z; w[j][3] = a.w; w[j][4] = b.x; w[j][5] = b.y; w[j][6] = b.z; w[j][7] = b.w; }
        { const f32x4 a = *(const f32x4*)(cb + c0), b = *(const f32x4*)(cb + c0 + 4); bias[0] = a.x; bias[1] = a.y; bias[2] = a.z; bias[3] = a.w; bias[4] = b.x; bias[5] = b.y; bias[6] = b.z; bias[7] = b.w; }
        const bool sample = r0 >= MP; const int sb = sample ? (r0 - MP) / 32 : 0;
        const bool start = sample || (r0 % SEQ) == 0;
#pragma unroll
        for (int i = 0; i < 8; ++i) { h3[i] = 0.f; h2[i] = 0.f; h1[i] = 0.f; }
        if (start) {
            if (sample) {
                const float* sp = sconv + (size_t)sb * 3 * DR + c0;
#pragma unroll
                for (int i = 0; i < 8; ++i) { h3[i] = sp[i]; h2[i] = sp[DR + i]; h1[i] = sp[2 * DR + i]; }
            }
        } else {
            const u32x4 a = *(const u32x4*)(PROJ2 + (size_t)(r0 - 3) * OIN + c0), b = *(const u32x4*)(PROJ2 + (size_t)(r0 - 2) * OIN + c0), c = *(const u32x4*)(PROJ2 + (size_t)(r0 - 1) * OIN + c0);
            h3[0] = bflo(a.x); h3[1] = bfhi(a.x); h3[2] = bflo(a.y); h3[3] = bfhi(a.y); h3[4] = bflo(a.z); h3[5] = bfhi(a.z); h3[6] = bflo(a.w); h3[7] = bfhi(a.w);
            h2[0] = bflo(b.x); h2[1] = bfhi(b.x); h2[2] = bflo(b.y); h2[3] = bfhi(b.y); h2[4] = bflo(b.z); h2[5] = bfhi(b.z); h2[6] = bflo(b.w); h2[7] = bfhi(b.w);
            h1[0] = bflo(c.x); h1[1] = bfhi(c.x); h1[2] = bflo(c.y); h1[3] = bfhi(c.y); h1[4] = bflo(c.z); h1[5] = bfhi(c.z); h1[6] = bflo(c.w); h1[7] = bfhi(c.w);
        }
        const bool endseq = sample || ((r0 + 32) % SEQ) == 0;
        float* ocv = sample ? out + O_CVS + (size_t)sb * 3 * DR + c0 : out + O_CVP + (size_t)(r0 / SEQ) * 3 * DR + c0;
#pragma unroll 8
        for (int i = 0; i < 32; ++i) {
            const u32x4 xw = *(const u32x4*)(PROJ2 + (size_t)(r0 + i) * OIN + c0);
            float x[8] = {bflo(xw.x), bfhi(xw.x), bflo(xw.y), bfhi(xw.y), bflo(xw.z), bfhi(xw.z), bflo(xw.w), bfhi(xw.w)};
            float cv[8];
#pragma unroll
            for (int e = 0; e < 8; ++e) { cv[e] = bias[e] + w[0][e] * h3[e] + w[1][e] * h2[e] + w[2][e] * h1[e] + w[3][e] * x[e]; h3[e] = h2[e]; h2[e] = h1[e]; h1[e] = x[e]; }
            u32x4 o; o.x = cvt_pk_bf16(cv[0], cv[1]); o.y = cvt_pk_bf16(cv[2], cv[3]); o.z = cvt_pk_bf16(cv[4], cv[5]); o.w = cvt_pk_bf16(cv[6], cv[7]);
            *(u32x4*)(XC + (size_t)(r0 + i) * DR + c0) = o;
            if (endseq && i >= 29) { float* op = ocv + (size_t)(i - 29) * DR; *(f32x4*)op = (f32x4){x[0], x[1], x[2], x[3]}; *(f32x4*)(op + 4) = (f32x4){x[4], x[5], x[6], x[7]}; }
        }
    }
}
__device__ __forceinline__ float em1neg(float x) {
    if (x > -0.25f) { float p = 1.0f + x * (1.0f / 8.0f); p = 1.0f + x * (1.0f / 7.0f) * p; p = 1.0f + x * (1.0f / 6.0f) * p; p = 1.0f + x * (1.0f / 5.0f) * p; p = 1.0f + x * (1.0f / 4.0f) * p; p = 1.0f + x * (1.0f / 3.0f) * p; p = 1.0f + x * 0.5f * p; return x * p; }
    return fexp(x) - 1.0f;
}
__device__ __forceinline__ float gelu_tanh(float y) { const float z2 = (-2.0f * 0.7978845608028654f * 1.4426950408889634f) * (y + 0.044715f * y * y * y); return y * frcp(1.0f + __builtin_amdgcn_exp2f(z2)); }
template <int PASS> __device__ __forceinline__ void scan_phase(const bf16_t* PROJ2, const bf16_t* GATES, const float* SP8, const float* cw, const float* cb, const float* sconv, const float* srg,
                                                                float* AGA, float* AGH, const float* CAR, bf16_t* MIXO2, float* out, int vcu, int G, int tid) {
    const int ntiles = PASS == 1 ? 256 : 288;
    for (int u = vcu; u < ntiles * 5; u += G) {
        const int tile = u / 5, cg = u % 5; const int c = cg * 1024 + tid * 2;
        const bool sample = tile >= 256; const int sb = tile - 256;
        const int r0 = sample ? MP + sb * 32 : tile * 64; const int nrow = sample ? 32 : 64;
        const bool first = !sample && (r0 % SEQ) == 0;
        const f32x2 sp = *(const f32x2*)(SP8 + c), bias = *(const f32x2*)(cb + c);
        const f32x2 w0 = *(const f32x2*)(cw + c), w1 = *(const f32x2*)(cw + DR + c), w2 = *(const f32x2*)(cw + 2 * DR + c), w3 = *(const f32x2*)(cw + 3 * DR + c);
        f32x2 h3 = {0.f, 0.f}, h2 = {0.f, 0.f}, h1 = {0.f, 0.f};
        if (sample) { const float* s = sconv + (size_t)sb * 3 * DR + c; h3 = *(const f32x2*)s; h2 = *(const f32x2*)(s + DR); h1 = *(const f32x2*)(s + 2 * DR); }
        else if (!first) { const unsigned a = *(const unsigned*)(PROJ2 + (size_t)(r0 - 3) * OIN + c), b = *(const unsigned*)(PROJ2 + (size_t)(r0 - 2) * OIN + c), d = *(const unsigned*)(PROJ2 + (size_t)(r0 - 1) * OIN + c);
            h3 = (f32x2){bflo(a), bfhi(a)}; h2 = (f32x2){bflo(b), bfhi(b)}; h1 = (f32x2){bflo(d), bfhi(d)}; }
        f32x2 hh = {0.f, 0.f}, aa = {1.f, 1.f};
        if (PASS == 2) hh = sample ? *(const f32x2*)(srg + (size_t)sb * DR + c) : *(const f32x2*)(CAR + (size_t)tile * DR + c);
        unsigned rw[2][8], iw[2][8], xw[2][8], yw[2][8];
#define SCAN_LOAD(buf, i0_) do { _Pragma("unroll") for (int i = 0; i < 8; ++i) { const size_t ro = (size_t)(r0 + (i0_) + i) * OIN + c; rw[buf][i] = *(const unsigned*)(GATES + ro); iw[buf][i] = *(const unsigned*)(GATES + ro + DR); \
            xw[buf][i] = *(const unsigned*)(PROJ2 + ro); if (PASS == 2) yw[buf][i] = *(const unsigned*)(PROJ2 + ro + DR); else yw[buf][i] = 0u; } } while (0)
#define SCAN_COMPUTE(buf, i0_) do { _Pragma("unroll") for (int i = 0; i < 8; ++i) { \
            const f32x2 x = {bflo(xw[buf][i]), bfhi(xw[buf][i])}, r = {bflo(rw[buf][i]), bfhi(rw[buf][i])}, ig = {bflo(iw[buf][i]), bfhi(iw[buf][i])}; \
            const f32x2 cv = bias + w0 * h3 + w1 * h2 + w2 * h1 + w3 * x; h3 = h2; h2 = h1; h1 = x; \
            const float a0 = __builtin_amdgcn_exp2f(-sp.x * r.x), a1 = __builtin_amdgcn_exp2f(-sp.y * r.y); \
            float m0 = __builtin_amdgcn_sqrtf(fmaf(-a0, a0, 1.0f)), m1 = __builtin_amdgcn_sqrtf(fmaf(-a1, a1, 1.0f)); \
            if (first && ((i0_) + i) == 0) { m0 = 1.0f; m1 = 1.0f; } \
            hh.x = a0 * hh.x + m0 * ig.x * cv.x; hh.y = a1 * hh.y + m1 * ig.y * cv.y; \
            if (PASS == 1) { aa.x *= a0; aa.y *= a1; } \
            else { const float o0 = gelu_tanh(bflo(yw[buf][i])) * hh.x, o1 = gelu_tanh(bfhi(yw[buf][i])) * hh.y; *(unsigned*)(MIXO2 + (size_t)(r0 + (i0_) + i) * DR + c) = cvt_pk_bf16(o0, o1); } } } while (0)
        SCAN_LOAD(0, 0);
        for (int i0 = 0; i0 < nrow; i0 += 16) {
            SCAN_LOAD(1, i0 + 8);
            SCAN_COMPUTE(0, i0);
            if (i0 + 16 < nrow) SCAN_LOAD(0, i0 + 16);
            SCAN_COMPUTE(1, i0 + 8);
        }
#undef SCAN_LOAD
#undef SCAN_COMPUTE
        if (PASS == 1) { *(f32x2*)(AGA + (size_t)tile * DR + c) = aa; *(f32x2*)(AGH + (size_t)tile * DR + c) = hh; }
        else if (sample) *(f32x2*)(out + O_RGS + (size_t)sb * DR + c) = hh;
    }
}
namespace gl {
constexpr int PX = 328, PG = 648;
constexpr int OFF_XC = 0, OFF_G = 64 * PX * 2, OFF_END = OFF_G + 64 * PG * 2;
constexpr int OFF_CST = LDSCTL_OFF + 1024;
static_assert(OFF_CST + 8 * 320 * 4 <= LDS_BYTES, "gate core constants");
static_assert(OFF_END <= RING_BYTES, "gate core LDS");
__device__ __forceinline__ void load_x(u32x4 (&xr)[11], const bf16_t* PROJ2, int tile, int blk, int tid) {
    const bool sample = tile >= 256; const int r0 = sample ? MP + (tile - 256) * 64 : tile * 64; const int L = 64; const bool start = sample || (tile & 127) == 0;
    const int c8 = tid % 40, tg = tid / 40; const int ch = blk * 320 + c8 * 8; const int t0 = tg * 8;
#pragma unroll
    for (int i = 0; i < 11; ++i) { const int t = t0 - 3 + i; xr[i] = (u32x4){0u, 0u, 0u, 0u};
        if (tid < 320 && t < L && (t >= 0 || !start)) xr[i] = __builtin_nontemporal_load((const u32x4*)(PROJ2 + (size_t)(r0 + t) * OIN + ch)); }
}
__device__ __forceinline__ void load_consts(LAS unsigned char* lds, const float* ga_b, const float* gx_b, const float* SP8, const float* cw, const float* cb, int blk, int tid) {
    LAS float* C = (LAS float*)(lds + OFF_CST);
    for (int i = tid; i < 8 * 320; i += 512) { const int a = i / 320, c = i % 320; const int ch = blk * 320 + c;
        C[i] = a < 4 ? cw[a * DR + ch] : a == 4 ? cb[ch] : a == 5 ? SP8[ch] : a == 6 ? ga_b[ch] : gx_b[ch]; }
}
__device__ __forceinline__ void unit(LAS unsigned char* lds, const bf16_t* PROJ2, const bf16_t* GW,
                                     const float* sconv, bf16_t* LAB, float* AGA, float* AGH, float* out, int tile, int blk, u32x4 (&xr)[11], int next_tile) {
    const LAS float* CST = (const LAS float*)(lds + OFF_CST);
    const int tid = tid_l(), wid = __builtin_amdgcn_readfirstlane(tid >> 6), lane = tid & 63, fr = lane & 15, fq = lane >> 4;
    LAS bf16_t* XC = (LAS bf16_t*)(lds + OFF_XC); LAS bf16_t* GT = (LAS bf16_t*)(lds + OFF_G);
    const bool sample = tile >= 256; const int sb2 = 2 * (tile - 256);
    const int r0 = sample ? MP + sb2 * DECS : tile * 64; const int L = 64;
    const bool start = sample || (tile & 127) == 0;
    const bool first = !sample && (tile & 127) == 0;
    const int cbase = blk * 320;
    if (tid < 320) {
        const int c8 = tid % 40, tg = tid / 40; const int ch = cbase + c8 * 8;
        float w[4][8], bias[8];
#pragma unroll
        for (int j = 0; j < 4; ++j) { const f32x4 a = *(const LAS f32x4*)(CST + j * 320 + c8 * 8), b = *(const LAS f32x4*)(CST + j * 320 + c8 * 8 + 4);
            w[j][0] = a.x; w[j][1] = a.y; w[j][2] = a.z; w[j][3] = a.w; w[j][4] = b.x; w[j][5] = b.y; w[j][6] = b.z; w[j][7] = b.w; }
        { const f32x4 a = *(const LAS f32x4*)(CST + 4 * 320 + c8 * 8), b = *(const LAS f32x4*)(CST + 4 * 320 + c8 * 8 + 4); bias[0] = a.x; bias[1] = a.y; bias[2] = a.z; bias[3] = a.w; bias[4] = b.x; bias[5] = b.y; bias[6] = b.z; bias[7] = b.w; }
        const int t0 = tg * 8;
        float h3[8], h2[8], h1[8];
#define GL_UNPACK(dst, v) do { dst[0] = bflo(v.x); dst[1] = bfhi(v.x); dst[2] = bflo(v.y); dst[3] = bfhi(v.y); dst[4] = bflo(v.z); dst[5] = bfhi(v.z); dst[6] = bflo(v.w); dst[7] = bfhi(v.w); } while (0)
        GL_UNPACK(h3, xr[0]); GL_UNPACK(h2, xr[1]); GL_UNPACK(h1, xr[2]);
        if (sample && (tg & 3) == 0) {
            const float* sp = sconv + (size_t)(sb2 + (tg >> 2)) * 3 * DR + ch;
#pragma unroll
            for (int e = 0; e < 8; ++e) { h3[e] = sp[e]; h2[e] = sp[DR + e]; h1[e] = sp[2 * DR + e]; } }
#pragma unroll
        for (int i = 0; i < 8; ++i) { float x[8], cv[8]; GL_UNPACK(x, xr[3 + i]);
#pragma unroll
            for (int e = 0; e < 8; ++e) { cv[e] = (t0 + i < L) ? bias[e] + w[0][e] * h3[e] + w[1][e] * h2[e] + w[2][e] * h1[e] + w[3][e] * x[e] : 0.f; h3[e] = h2[e]; h2[e] = h1[e]; h1[e] = x[e]; }
            u32x4 o; o.x = cvt_pk_bf16(cv[0], cv[1]); o.y = cvt_pk_bf16(cv[2], cv[3]); o.z = cvt_pk_bf16(cv[4], cv[5]); o.w = cvt_pk_bf16(cv[6], cv[7]);
            *(LAS u32x4*)(XC + (t0 + i) * PX + c8 * 8) = o; }
        if ((sample && (tg & 3) == 3) || (!sample && (tile & 127) == 127 && tg == 7)) { float* oc = sample ? out + O_CVS + (size_t)(sb2 + (tg >> 2)) * 3 * DR + ch : out + O_CVP + (size_t)(tile >> 7) * 3 * DR + ch;
            *(f32x4*)oc = (f32x4){h3[0], h3[1], h3[2], h3[3]}; *(f32x4*)(oc + 4) = (f32x4){h3[4], h3[5], h3[6], h3[7]};
            *(f32x4*)(oc + DR) = (f32x4){h2[0], h2[1], h2[2], h2[3]}; *(f32x4*)(oc + DR + 4) = (f32x4){h2[4], h2[5], h2[6], h2[7]};
            *(f32x4*)(oc + 2 * DR) = (f32x4){h1[0], h1[1], h1[2], h1[3]}; *(f32x4*)(oc + 2 * DR + 4) = (f32x4){h1[4], h1[5], h1[6], h1[7]}; }
#undef GL_UNPACK
    }
    __syncthreads();
    {
        const bf16_t* grow[5];
#pragma unroll
        for (int t = 0; t < 5; ++t) grow[t] = GW + (size_t)blk * GWN * GWK + ((size_t)(wid * 5 + t) * 10 * 64 + lane) * 8;
        f32x4 acc[5][4];
#pragma unroll
        for (int t = 0; t < 5; ++t)
#pragma unroll
            for (int tt = 0; tt < 4; ++tt) acc[t][tt] = (f32x4){0.f, 0.f, 0.f, 0.f};
        bf16x8 Aw[4][5];
#pragma unroll
        for (int t = 0; t < 5; ++t) { Aw[0][t] = *(const bf16x8*)(grow[t]); Aw[1][t] = *(const bf16x8*)(grow[t] + 512); Aw[2][t] = *(const bf16x8*)(grow[t] + 1024); Aw[3][t] = *(const bf16x8*)(grow[t] + 1536); }
#pragma unroll
        for (int kk = 0; kk < 10; ++kk) {
            bf16x8 Bx[4];
#pragma unroll
            for (int tt = 0; tt < 4; ++tt) Bx[tt] = *(const LAS bf16x8*)(XC + (tt * 16 + fr) * PX + kk * 32 + 8 * fq);
#pragma unroll
            for (int t = 0; t < 5; ++t)
#pragma unroll
                for (int tt = 0; tt < 4; ++tt) acc[t][tt] = __builtin_amdgcn_mfma_f32_16x16x32_bf16(Aw[kk % 4][t], Bx[tt], acc[t][tt], 0, 0, 0);
            if ((kk & 1) && kk + 3 < 10) {
#pragma unroll
                for (int t = 0; t < 5; ++t) { Aw[(kk + 3) % 4][t] = *(const bf16x8*)(grow[t] + (kk + 3) * 512); Aw[(kk + 4) % 4][t] = *(const bf16x8*)(grow[t] + (kk + 4) * 512); } }
        }
        if (next_tile >= 0) load_x(xr, PROJ2, next_tile, blk, tid);
#pragma unroll
        for (int t = 0; t < 5; ++t) { const int c = wid * 40 + 8 * t + 2 * fq;
            const f32x2 ba2 = *(const LAS f32x2*)(CST + 6 * 320 + c), bx2 = *(const LAS f32x2*)(CST + 7 * 320 + c), sp2 = *(const LAS f32x2*)(CST + 5 * 320 + c);
#pragma unroll
            for (int tt = 0; tt < 4; ++tt) { const int tok = tt * 16 + fr; const f32x4 v = acc[t][tt];
                const float r0 = sigm(v[0] + ba2.x), r1 = sigm(v[1] + ba2.y), i0 = sigm(v[2] + bx2.x), i1 = sigm(v[3] + bx2.y);
                const unsigned xw = *(const LAS unsigned*)(XC + tok * PX + c);
                const float la0 = -sp2.x * r0, la1 = -sp2.y * r1; const float a0 = __builtin_amdgcn_exp2f(la0), a1 = __builtin_amdgcn_exp2f(la1);
                float m0 = __builtin_amdgcn_sqrtf(fmaf(-a0, a0, 1.0f)), m1 = __builtin_amdgcn_sqrtf(fmaf(-a1, a1, 1.0f));
                if (first && tok == 0) { m0 = 1.0f; m1 = 1.0f; }
                *(LAS unsigned*)(GT + tok * PG + c) = cvt_pk_bf16(la0, la1);
                *(LAS unsigned*)(GT + tok * PG + 320 + c) = cvt_pk_bf16(m0 * i0 * bflo(xw), m1 * i1 * bfhi(xw)); } }
    }
    __syncthreads();
    {
        const int tok = tid >> 3, sub = tid & 7;
        if (tok < L) {
#pragma unroll
            for (int i = 0; i < 5; ++i) { const int c8 = sub + 8 * i;
                const u32x4 lw = *(const LAS u32x4*)(GT + tok * PG + c8 * 8), bw = *(const LAS u32x4*)(GT + tok * PG + 320 + c8 * 8);
                bf16_t* gp = LAB + (size_t)(r0 + tok) * OIN + cbase + c8 * 8; __builtin_nontemporal_store(lw, (u32x4*)gp); __builtin_nontemporal_store(bw, (u32x4*)(gp + DR)); } }
    }
    if (!sample && tid < 320) { float h = 0.f, ls = 0.f;
        typedef short s16x4 __attribute__((ext_vector_type(4)));
        const int q = fr >> 2, p = fr & 3; const LAS bf16_t* gp = GT + q * PG + (tid & ~15) + 4 * p;
#pragma unroll 4
        for (int t0 = 0; t0 < 64; t0 += 4) {
            const s16x4 lw = __builtin_amdgcn_ds_read_tr16_b64_v4i16((LAS s16x4*)(gp + t0 * PG)), bw = __builtin_amdgcn_ds_read_tr16_b64_v4i16((LAS s16x4*)(gp + t0 * PG + 320));
#pragma unroll
            for (int e = 0; e < 4; ++e) { const float la = bf1((bf16_t)lw[e]), b = bf1((bf16_t)bw[e]); h = __builtin_amdgcn_exp2f(la) * h + b; ls += la; } }
        AGA[(size_t)tile * DR + cbase + tid] = __builtin_amdgcn_exp2f(ls); AGH[(size_t)tile * DR + cbase + tid] = h; }
}
}
__device__ __forceinline__ void scanB_phase(const bf16_t* PROJ2, const bf16_t* LAB, const float* srg, const float* CAR, bf16_t* MIXO2, float* out, int vcu, int G, int tid) {
    for (int u = vcu; u < 288 * 5; u += G) {
        const int tile = u / 5, cg = u % 5; const int c = cg * 1024 + tid * 2;
        const bool sample = tile >= 256; const int sb = tile - 256;
        const int r0 = sample ? MP + sb * 32 : tile * 64; const int nrow = sample ? 32 : 64;
        f32x2 hh = sample ? *(const f32x2*)(srg + (size_t)sb * DR + c) : *(const f32x2*)(CAR + (size_t)tile * DR + c);
        unsigned lw[2][8], bw[2][8], yw[2][8];
#define SB_LOAD(buf, i0_) do { _Pragma("unroll") for (int i = 0; i < 8; ++i) { const size_t ro = (size_t)(r0 + (i0_) + i) * OIN + c; lw[buf][i] = *(const unsigned*)(LAB + ro); bw[buf][i] = *(const unsigned*)(LAB + ro + DR); yw[buf][i] = *(const unsigned*)(PROJ2 + ro + DR); } } while (0)
#define SB_COMPUTE(buf, i0_) do { _Pragma("unroll") for (int i = 0; i < 8; ++i) { \
            hh.x = __builtin_amdgcn_exp2f(bflo(lw[buf][i])) * hh.x + bflo(bw[buf][i]); hh.y = __builtin_amdgcn_exp2f(bfhi(lw[buf][i])) * hh.y + bfhi(bw[buf][i]); \
            *(unsigned*)(MIXO2 + (size_t)(r0 + (i0_) + i) * DR + c) = cvt_pk_bf16(gelu_tanh(bflo(yw[buf][i])) * hh.x, gelu_tanh(bfhi(yw[buf][i])) * hh.y); } } while (0)
        SB_LOAD(0, 0);
        for (int i0 = 0; i0 < nrow; i0 += 16) {
            SB_LOAD(1, i0 + 8);
            SB_COMPUTE(0, i0);
            if (i0 + 16 < nrow) SB_LOAD(0, i0 + 16);
            SB_COMPUTE(1, i0 + 8);
        }
#undef SB_LOAD
#undef SB_COMPUTE
        if (sample) *(f32x2*)(out + O_RGS + (size_t)sb * DR + c) = hh;
    }
}
__device__ __forceinline__ void carry_phase(const float* AGA, const float* AGH, float* CAR, float* out, int vcu, int tid) {
    const int wave = tid >> 6, lane = tid & 63, ci = lane & 15, seg = lane >> 4;
    const int chain = (vcu * NWAVES + wave) * 16 + ci; if ((vcu * NWAVES + wave) * 16 >= NBATCH * DR) return;
    const int b = chain / DR, c = chain % DR; const size_t base = (size_t)(b * 128 + seg * 32) * DR + c;
    float a[32], hv[32];
#pragma unroll
    for (int j = 0; j < 32; ++j) { a[j] = AGA[base + (size_t)j * DR]; hv[j] = AGH[base + (size_t)j * DR]; }
    float A = 1.f, H = 0.f;
#pragma unroll
    for (int j = 0; j < 32; ++j) { H = a[j] * H + hv[j]; A *= a[j]; }
    const float H0 = __shfl(H, ci), H1 = __shfl(H, ci + 16), H2 = __shfl(H, ci + 32), A1 = __shfl(A, ci + 16), A2 = __shfl(A, ci + 32);
    const float c1 = H0, c2 = A1 * c1 + H1, c3 = A2 * c2 + H2;
    float carry = seg == 0 ? 0.f : seg == 1 ? c1 : seg == 2 ? c2 : c3;
#pragma unroll
    for (int j = 0; j < 32; ++j) { CAR[base + (size_t)j * DR] = carry; carry = a[j] * carry + hv[j]; }
    if (seg == 3) out[O_RGP + (size_t)b * DR + c] = carry;
}

constexpr int NPH = 20;
struct Args { const float* in[25]; float* out; unsigned char* ws; int ph_lo, ph_hi; };
static_assert(sizeof(Args) == 224, "Args has no padding");
typedef __attribute__((address_space(4))) const unsigned char* kargp_t;
__device__ __forceinline__ kargp_t kargs() { kargp_t kp = (kargp_t)__builtin_amdgcn_kernarg_segment_ptr(); asm volatile("" : "+s"(kp)); return kp; }
#define KIN(i) (*(const float* const __attribute__((address_space(4)))*)(kargs() + 8 * (i)))
#define KOUT() (*(float* const __attribute__((address_space(4)))*)(kargs() + 200))
#define KWS() (*(unsigned char* const __attribute__((address_space(4)))*)(kargs() + 208))
__global__ void __launch_bounds__(NWAVES * 64, 2) fwd(Args args_unused) {
    extern __shared__ __attribute__((aligned(16))) unsigned char lds_raw[];
    LAS unsigned char* lds = (LAS unsigned char*)lds_raw;
#define tid (tid_l())
#define lane (tid_l() & 63)
    const int wave = __builtin_amdgcn_readfirstlane(tid >> 6);
    const int G = gridDim.x; const int bx = blockIdx.x; const int vcu = (G % 8 == 0) ? (bx % 8) * (G / 8) + bx / 8 : bx;
    const int gw = vcu * NWAVES + wave, NGW = G * NWAVES;
    for (int u = tid; u < (LDS_BYTES - LDSCTL_OFF) / 4; u += NWAVES * 64) ((LAS unsigned*)(lds + LDSCTL_OFF))[u] = 0u;
    __syncthreads();
    volatile LAS unsigned* MISC = (volatile LAS unsigned*)(lds + MISC_OFF);
    XcdBarrier bar; bar.bar = (unsigned*)(KWS() + WS_CTL) + CW_BAR; bar.x = 0; bar.st = nullptr;
    bar = xcd_barrier_post((unsigned*)(KWS() + WS_CTL) + CW_BAR, MISC + 8);
    const int lo = *(const int __attribute__((address_space(4)))*)(kargs() + 216), hi = *(const int __attribute__((address_space(4)))*)(kargs() + 220);
#define IN(k) (lo <= (k) && (k) < hi)
    unsigned* const bgctl = (unsigned*)(KWS() + WS_CTL);
#define SEAM(k) do { if (IN(k) && IN((k) + 1)) xcd_barrier_bg(bar, bgctl, lds, MISC + 16); } while (0)
#define DRAIN(e) bg_drain(bgctl, (unsigned)(e), lds, MISC + 16)

    if (IN(0)) {
        unsigned char* ws = KWS();
        LAS float* scr = (LAS float*)(lds + wave * 16384);
        constexpr int I_INE = (D / 64) * (EIN / 32);
        for (int it = gw; it < I_INE; it += 2 * NGW) {
            constexpr int nblk = EIN / 32; const int it2 = it + NGW; const bool two = it2 < I_INE;
            BgItem a, b; a.W = KIN(9); a.WT = (bf16_t*)(ws + WS_WINE); a.gain = nullptr; a.ldw = EIN; a.ldo = D; a.perm = 0; a.k0 = 64 * (it / nblk); a.n0 = 32 * (it % nblk);
            b = a; if (two) { b.k0 = 64 * (it2 / nblk); b.n0 = 32 * (it2 % nblk); }
            f32x4 va[8], vb[8];
            bg_load(va, a, lane); if (two) bg_load(vb, b, lane);
            bg_finish<false>(va, a, scr, lane); if (two) bg_finish<false>(vb, b, scr, lane); }
        { const float* lb_logits = KIN(10); float* LB = (float*)(ws + WS_LB);
          for (int i = gw * 64 + lane; i < 2048; i += NGW * 64) { const float a = lb_logits[i], b = lb_logits[2048 + i], c = lb_logits[4096 + i]; const float mx = fmaxf(a, fmaxf(b, c));
            const float ea = fexp(a - mx), eb = fexp(b - mx), ec = fexp(c - mx); LB[i] = ea / (ea + eb + ec); } }
        { const float* lam = KIN(21); float* SP8 = (float*)(ws + WS_SP8);
          for (int i = gw * 64 + lane; i < DR; i += NGW * 64) { const float l = -lam[i]; const float e = fexp(-fabsf(l)); const float l1p = e < 1e-4f ? e * (1.0f - 0.5f * e) : flog(1.0f + e); SP8[i] = 8.0f * 1.4426950408889634f * (fmaxf(l, 0.f) + l1p);     } }
        { f32x2* ROT = (f32x2*)(ws + WS_ROT);
          for (int i = gw * 64 + lane; i < SEQ * 64; i += NGW * 64) { const int pos = i >> 6, fi = i & 63; const float inv = __builtin_amdgcn_exp2f(-(float)fi * (13.287712379549449f / 63.0f));
            const float ang = (float)pos * inv; const float rev = ang * 0.15915494309189535f; const float fr_ = rev - floorf(rev);
            ROT[i] = (f32x2){__builtin_amdgcn_cosf(fr_), __builtin_amdgcn_sinf(fr_)}; } }
        rms_phase<false>(KIN(0), KIN(1), nullptr, nullptr, KIN(6), (bf16_t*)(ws + WS_XN), nullptr, gw, NGW, lane);
    }
    SEAM(0);
    if (IN(1)) { unsigned char* ws = KWS(); pg8::Gemm g{(bf16_t*)(ws + WS_XN), (bf16_t*)(ws + WS_WINE), D, D, D, 0, 0}; pg8::StaticOrder S; S.init(M, EIN, G, bx); pg8::EpiBf16<0> E{(bf16_t*)(ws + WS_PROJ), EIN, nullptr};
        pg8::gemm_phase<pg8::EpiBf16<0>, pg8::StaticOrder, true>(lds, g, S, E); }
    SEAM(1);
    if (IN(2)) {
        unsigned char* ws = KWS();
        { bf16_t* PROJ = (bf16_t*)(ws + WS_PROJ); const float* LB = (const float*)(ws + WS_LB); const f32x2* ROT = (const f32x2*)(ws + WS_ROT); float* DECB = (float*)(ws + WS_AGA);
          const int el = tid >> 3, kc = (tid & 7) * 8; constexpr int NU = mix::NCHUNK * 24;
          mix::Raw rcur, rnxt; int row0, L, pos0, hd, cidx;
          if (vcu < NU) { mix::prep_decode(vcu, row0, L, pos0, hd, cidx); mix::prep_load(rcur, PROJ, ROT, row0, L, pos0, hd, el, kc); }
          for (int u = vcu; u < NU; u += G) {
              int row0n = 0, Ln = 0, pos0n = 0, hdn = 0, cidxn = 0;
              if (u + G < NU) { mix::prep_decode(u + G, row0n, Ln, pos0n, hdn, cidxn); mix::prep_load(rnxt, PROJ, ROT, row0n, Ln, pos0n, hdn, el, kc); }
              mix::prep_unit(lds, rcur, PROJ, LB, DECB, row0, L, hd, cidx, tid);
              rcur = rnxt; row0 = row0n; L = Ln; pos0 = pos0n; hd = hdn; cidx = cidxn;
          } }
        xcd_barrier_bg(bar, bgctl, lds, MISC + 16);
        { float* out = KOUT();
          const bf16_t* PROJ = (const bf16_t*)(ws + WS_PROJ); bf16_t* ORAW = (bf16_t*)(ws + WS_ORAW); const float* DECB = (const float*)(ws + WS_AGA);
          {
            for (int it = vcu; it < 256; it += G) {
                const int kind = it >> 7, r = it & 127, b = r >> 6; int h, vs; if (kind == 0) { h = (r >> 2) & 15; vs = r & 3; } else { h = (r >> 3) & 7; vs = r & 7; }
                if (kind == 0) mix::chain<0, false>(lds, PROJ, ORAW, DECB, b * SEQ, SEQ / 64, b * (SEQ / 64), 0, 0, h, vs, nullptr, out + O_HGP + (size_t)b * 16 * 16384);
                else mix::chain<1, false>(lds, PROJ, ORAW, DECB, b * SEQ, SEQ / 64, b * (SEQ / 64), 0, 0, h, vs, nullptr, out + O_RTP + (size_t)b * 8 * 32768);
                __syncthreads();
            }
            if ((G % 128) == 0 && (32 % (G >> 7)) == 0) {
                const int r = vcu & 127, sb0 = vcu >> 7, sbs = G >> 7, n = 32 / sbs;
                if (r < 64) mix::chain<0, true>(lds, PROJ, ORAW, DECB, 0, n, 0, sb0, sbs, r >> 2, r & 3, KIN(2), out + O_HGS);
                else mix::chain<1, true>(lds, PROJ, ORAW, DECB, 0, n, 0, sb0, sbs, (r - 64) >> 3, r & 7, KIN(3), out + O_RTS);
                __syncthreads();
            } else {
                for (int it = vcu; it < 4096; it += G) { const int sb = it >> 7, r = it & 127;
                    if (r < 64) mix::chain<0, true>(lds, PROJ, ORAW, DECB, 0, 1, 0, sb, 0, r >> 2, r & 3, KIN(2), out + O_HGS);
                    else mix::chain<1, true>(lds, PROJ, ORAW, DECB, 0, 1, 0, sb, 0, (r - 64) >> 3, r & 7, KIN(3), out + O_RTS);
                    __syncthreads(); }
            }
          } }
    }
    SEAM(2);
    if (IN(3)) { unsigned char* ws = KWS(); headnorm_phase((const bf16_t*)(ws + WS_ORAW), (const bf16_t*)(ws + WS_PROJ), KIN(11), KIN(12), (bf16_t*)(ws + WS_MIXO), gw, NGW, lane); }
    DRAIN(BG_E1);
    SEAM(3);
    if (IN(4)) { unsigned char* ws = KWS();
        { pg8::Gemm g{(bf16_t*)(ws + WS_MIXO), (bf16_t*)(ws + WS_WOUTE), D, D, D, 0, 0}; pg8::StaticOrder S; S.init(MP, D, G, bx); pg8::EpiResNorm<true> E{KIN(0), (bf16_t*)(ws + WS_XN), (float*)(ws + WS_CAR)};
          pg8::gemm_phase<pg8::EpiResNorm<true>, pg8::StaticOrder, true>(lds, g, S, E); }
        { pg8::Gemm g{(bf16_t*)(ws + WS_MIXO), (bf16_t*)(ws + WS_WOUTE), D, D, D / 4, (size_t)(D / 4) * 2, (size_t)(D / 4) * 2}; pg8::SplitOrder S{G, bx}; pg8::EpiPart E{(bf16_t*)(ws + WS_PART)};
          pg8::gemm_phase<pg8::EpiPart, pg8::SplitOrder, true>(lds, g, S, E); } }
    SEAM(4);
    if (IN(5)) { unsigned char* ws = KWS(); float* out = KOUT(); mini_norm_phase(KIN(1), (const bf16_t*)(ws + WS_PART), (bf16_t*)(ws + WS_XN), (const float*)(ws + WS_CAR), (float*)(ws + WS_AGH), gw, NGW, lane, vcu, G, tid); }
    DRAIN(BG_E2);
    SEAM(5);
    if (IN(6)) { unsigned char* ws = KWS(); pg8::Gemm g{(bf16_t*)(ws + WS_XN), (bf16_t*)(ws + WS_WUP), D, D, D, 0, 0}; pg8::StaticOrder S; S.init(M, FF, G, bx); pg8::EpiBf16<1> E{(bf16_t*)(ws + WS_HID), FF, (const float*)(ws + WS_AGH)};
        pg8::gemm_phase<pg8::EpiBf16<1>, pg8::StaticOrder, true>(lds, g, S, E); }
    DRAIN(BG_E3);
    SEAM(6);
    if (IN(7)) { unsigned char* ws = KWS(); float* out = KOUT();
        { pg8::Gemm g{(bf16_t*)(ws + WS_HID), (bf16_t*)(ws + WS_WDN), FF, FF, FF, 0, 0}; pg8::StaticOrder S; S.init(MP, D, G, bx); pg8::EpiResNorm<false> E{nullptr, (bf16_t*)(ws + WS_XN), (float*)(ws + WS_CAR)};
          pg8::gemm_phase<pg8::EpiResNorm<false>, pg8::StaticOrder, true>(lds, g, S, E); }
        { pg8::Gemm g{(bf16_t*)(ws + WS_HID), (bf16_t*)(ws + WS_WDN), FF, FF, FF / 4, (size_t)(FF / 4) * 2, (size_t)(FF / 4) * 2}; pg8::SplitOrder S{G, bx}; pg8::EpiPart E{(bf16_t*)(ws + WS_PART)};
          pg8::gemm_phase<pg8::EpiPart, pg8::SplitOrder, true>(lds, g, S, E); } }
    SEAM(7);
    if (IN(8)) { unsigned char* ws = KWS(); float* out = KOUT(); mini_norm_phase(nullptr, (const bf16_t*)(ws + WS_PART), (bf16_t*)(ws + WS_XN), (const float*)(ws + WS_CAR), (float*)(ws + WS_AGH), gw, NGW, lane, vcu, G, tid); }
    DRAIN(BG_E4);
    SEAM(8);
    if (IN(9)) { unsigned char* ws = KWS(); pg8::Gemm g{(bf16_t*)(ws + WS_XN), (bf16_t*)(ws + WS_WINO), D, D, D, 0, 0}; pg8::StaticOrder S; S.init(M, OIN, G, bx); pg8::EpiBf16<0> E{(bf16_t*)(ws + WS_PROJ2), OIN, (const float*)(ws + WS_AGH)};
        pg8::gemm_phase<pg8::EpiBf16<0>, pg8::StaticOrder, true>(lds, g, S, E); }
    DRAIN(BG_E5);
    SEAM(9);
    if (IN(10)) { unsigned char* ws = KWS(); float* out = KOUT();
        const bool xl = (G == 256); const int nu = xl ? 17 : (272 * 16 - vcu + G - 1) / G;
        const int blk0 = xl ? 2 * (vcu >> 5) + (vcu & 1) : (vcu & 15);
        const bool fixed_blk = xl || (G % 16) == 0;
        u32x4 xr[11];
        int tile = xl ? ((vcu & 31) >> 1) : (vcu >> 4), blk = blk0;
        if (nu > 0) { gl::load_consts(lds, KIN(18), KIN(20), (const float*)(ws + WS_SP8), KIN(15), KIN(16), blk, tid); gl::load_x(xr, (const bf16_t*)(ws + WS_PROJ2), tile, blk, tid); __syncthreads(); }
        for (int i = 0; i < nu; ++i) {
            int ntile = -1, nblk = blk;
            if (i + 1 < nu) { if (xl) ntile = tile + 16; else { const int u2 = vcu + G * (i + 1); ntile = u2 >> 4; nblk = u2 & 15; } }
            gl::unit(lds, (const bf16_t*)(ws + WS_PROJ2), (const bf16_t*)(ws + WS_GW), KIN(5), (bf16_t*)(ws + WS_GATES), (float*)(ws + WS_AGA), (float*)(ws + WS_AGH), out, tile, blk, xr, fixed_blk ? ntile : -1);
            if (!fixed_blk && ntile >= 0) { __syncthreads(); gl::load_consts(lds, KIN(18), KIN(20), (const float*)(ws + WS_SP8), KIN(15), KIN(16), nblk, tid); gl::load_x(xr, (const bf16_t*)(ws + WS_PROJ2), ntile, nblk, tid); __syncthreads(); }
            tile = ntile; blk = nblk; }
        __syncthreads(); }
    SEAM(10);
    if (IN(13)) { unsigned char* ws = KWS(); carry_phase((const float*)(ws + WS_AGA), (const float*)(ws + WS_AGH), (float*)(ws + WS_CAR), KOUT(), vcu, tid); }
    SEAM(13);
    if (IN(14)) { unsigned char* ws = KWS(); scanB_phase((const bf16_t*)(ws + WS_PROJ2), (const bf16_t*)(ws + WS_GATES), KIN(4), (const float*)(ws + WS_CAR), (bf16_t*)(ws + WS_XC), KOUT(), vcu, G, tid); }
    DRAIN(BG_E6);
    SEAM(14);
    if (IN(15)) { unsigned char* ws = KWS(); float* out = KOUT();
        { pg8::Gemm g{(bf16_t*)(ws + WS_XC), (bf16_t*)(ws + WS_WOUTO), DR, DR, DR, 0, 0}; pg8::StaticOrder S; S.init(MP, D, G, bx); pg8::EpiResNorm<false> E{nullptr, (bf16_t*)(ws + WS_XN), (float*)(ws + WS_CAR)};
          pg8::gemm_phase<pg8::EpiResNorm<false>, pg8::StaticOrder, true>(lds, g, S, E); }
        { pg8::Gemm g{(bf16_t*)(ws + WS_XC), (bf16_t*)(ws + WS_WOUTO), DR, DR, DR / 4, (size_t)(DR / 4) * 2, (size_t)(DR / 4) * 2}; pg8::SplitOrder S{G, bx}; pg8::EpiPart E{(bf16_t*)(ws + WS_PART)};
          pg8::gemm_phase<pg8::EpiPart, pg8::SplitOrder, true>(lds, g, S, E); } }
    SEAM(15);
    if (IN(16)) { unsigned char* ws = KWS(); float* out = KOUT(); mini_norm_phase(nullptr, (const bf16_t*)(ws + WS_PART), (bf16_t*)(ws + WS_XN), (const float*)(ws + WS_CAR), (float*)(ws + WS_AGH), gw, NGW, lane, vcu, G, tid); }
    DRAIN(BG_E7);
    SEAM(16);
    if (IN(17)) { unsigned char* ws = KWS(); pg8::Gemm g{(bf16_t*)(ws + WS_XN), (bf16_t*)(ws + WS_WUP) + (size_t)D * FF, D, D, D, 0, 0}; pg8::StaticOrder S; S.init(M, FF, G, bx); pg8::EpiBf16<1> E{(bf16_t*)(ws + WS_HID), FF, (const float*)(ws + WS_AGH)};
        pg8::gemm_phase<pg8::EpiBf16<1>, pg8::StaticOrder, true>(lds, g, S, E); }
    DRAIN(BG_E8);
    SEAM(17);
    if (IN(18)) { unsigned char* ws = KWS(); float* out = KOUT();
        { pg8::Gemm g{(bf16_t*)(ws + WS_HID), (bf16_t*)(ws + WS_WDN) + (size_t)D * FF, FF, FF, FF, 0, 0}; pg8::StaticOrder S; S.init(MP, D, G, bx); pg8::EpiResNorm<false> E{nullptr, (bf16_t*)(ws + WS_XN), (float*)(ws + WS_CAR)};
          pg8::gemm_phase<pg8::EpiResNorm<false>, pg8::StaticOrder, true>(lds, g, S, E); }
        { pg8::Gemm g{(bf16_t*)(ws + WS_HID), (bf16_t*)(ws + WS_WDN) + (size_t)D * FF, FF, FF, FF / 4, (size_t)(FF / 4) * 2, (size_t)(FF / 4) * 2}; pg8::SplitOrder S{G, bx}; pg8::EpiPart E{(bf16_t*)(ws + WS_PART)};
          pg8::gemm_phase<pg8::EpiPart, pg8::SplitOrder, true>(lds, g, S, E); } }
    SEAM(18);
    if (IN(19)) { unsigned char* ws = KWS(); final_norm_phase((const bf16_t*)(ws + WS_XN), (const bf16_t*)(ws + WS_PART), KIN(8), KOUT(), gw, NGW, lane); }
#undef IN
#undef SEAM
#undef DRAIN
#undef tid
#undef lane
}

extern "C" void kernel_launch(void* const* d_in, const int* in_sizes, int n_in, void* d_out, int out_size, void* d_ws, size_t ws_size, hipStream_t stream) {
    static int grid = 0;
    if (grid == 0) {
        if (n_in != 25 || (size_t)out_size != O_END || ws_size < WS_END) { fprintf(stderr, "kernel_launch: unexpected shapes (n_in %d, out %d, ws %zu); nothing launched\n", n_in, out_size, ws_size); grid = -1; return; }
        int dev = 0, cus = 0, per_cu = 0;
        if (hipGetDevice(&dev) != hipSuccess || hipDeviceGetAttribute(&cus, hipDeviceAttributeMultiprocessorCount, dev) != hipSuccess) { grid = -1; return; }
        if (hipFuncSetAttribute((const void*)fwd, hipFuncAttributeMaxDynamicSharedMemorySize, LDS_BYTES) != hipSuccess) { fprintf(stderr, "kernel_launch: hipFuncSetAttribute failed\n"); grid = -1; return; }
        if (hipOccupancyMaxActiveBlocksPerMultiprocessor(&per_cu, (const void*)fwd, NWAVES * 64, LDS_BYTES) != hipSuccess || per_cu < 1) { fprintf(stderr, "kernel_launch: occupancy query says %d\n", per_cu); }
        (void)hipGetLastError();
        grid = cus;
    }
    if (grid < 0) return;
    if (hipMemsetAsync((char*)d_ws + WS_CTL, 0, CTL_ZERO_BYTES, stream) != hipSuccess) return;
    Args a{};
    for (int i = 0; i < 25; ++i) a.in[i] = (const float*)d_in[i];
    a.out = (float*)d_out; a.ws = (unsigned char*)d_ws;
    a.ph_lo = 0; a.ph_hi = NPH;
    hipLaunchKernelGGL(fwd, dim3(grid), dim3(NWAVES * 64), LDS_BYTES, stream, a);
}
```
